# Optimizing an MI355X kernel written in HIP

```python
import jax, jax.numpy as jnp
from jax import lax
import numpy as np

D_MODEL = 1024
BATCH = 16
SEQ = 4096
DEPTH = 1
DEC_BATCH = 32
DEC_SEQ = 16
PAST_LEN = 1024

CHUNK = 64
N_HEADS = 16
N_KV_HEADS = 4
HEAD_DIM = 64
Q_GROUP = N_HEADS // N_KV_HEADS
ATT_WIDTH = N_HEADS * HEAD_DIM
KV_WIDTH = N_KV_HEADS * HEAD_DIM
WINDOW = 128
WIN_CHUNKS = WINDOW // CHUNK
D_RNN = D_MODEL
N_LRU_BLOCKS = 8
LRU_BLOCK = D_RNN // N_LRU_BLOCKS
CONV_WIDTH = 4
LRU_C = 8.0
D_FF = 2816
EPS = 1e-6
NEG_INF = -1e30
ATT_SCALE = HEAD_DIM ** -0.5
SPLIT_POINTS = (D_RNN, 2 * D_RNN, 2 * D_RNN + ATT_WIDTH, 2 * D_RNN + ATT_WIDTH + KV_WIDTH,
                2 * D_RNN + ATT_WIDTH + 2 * KV_WIDTH, 2 * D_RNN + ATT_WIDTH + 2 * KV_WIDTH + D_MODEL)
D_IN = 2 * D_RNN + ATT_WIDTH + 2 * KV_WIDTH + 2 * D_MODEL

kernel_name = 'hawk_swa_sink_macaron_stream_step'


def rms_norm(x, g):
    x32 = x.astype(jnp.float32)
    y = x32 * lax.rsqrt(jnp.mean(x32 * x32, axis=-1, keepdims=True) + EPS)
    return (y * g.astype(jnp.float32)).astype(x.dtype)


def swiglu(x, w_gate, w_up, w_down):
    return (jax.nn.silu(x @ w_gate) * (x @ w_up)) @ w_down


def causal_conv(xin, prev, w, b):
    T = xin.shape[1]
    xp = jnp.concatenate([prev.astype(xin.dtype), xin], axis=1)
    out = b + sum(xp[:, j:j + T] * w[j] for j in range(CONV_WIDTH))
    return out, xp[:, -(CONV_WIDTH - 1):]


def rg_lru(xc, h0, w_rg, b_rg, w_ig, b_ig, lam):
    B, T, _ = xc.shape
    x32 = xc.astype(jnp.float32)
    xb = x32.reshape(B, T, N_LRU_BLOCKS, LRU_BLOCK)
    r = jax.nn.sigmoid(jnp.einsum('btnd,nde->btne', xb, w_rg.astype(jnp.float32)) + b_rg.astype(jnp.float32))
    i = jax.nn.sigmoid(jnp.einsum('btnd,nde->btne', xb, w_ig.astype(jnp.float32)) + b_ig.astype(jnp.float32))
    r = r.reshape(B, T, D_RNN)
    i = i.reshape(B, T, D_RNN)
    log_a = -LRU_C * r * jax.nn.softplus(-lam.astype(jnp.float32))
    a = jnp.exp(log_a)
    bterm = jnp.sqrt(-jnp.expm1(2.0 * log_a)) * (i * x32)
    bterm = bterm.at[:, 0].add(a[:, 0] * h0.astype(jnp.float32))

    def combine(left, right):
        a1, b1 = left
        a2, b2 = right
        return a1 * a2, a2 * b1 + b2

    _, h = lax.associative_scan(combine, (a, bterm), axis=1)
    return h.astype(xc.dtype), h[:, -1].astype(h0.dtype)


def sink_probs(scores, valid, sinks):
    s = jnp.where(valid, scores, NEG_INF)
    sink = sinks.astype(jnp.float32).reshape(N_KV_HEADS, Q_GROUP, 1, 1)
    m = jnp.maximum(jnp.max(s, axis=-1, keepdims=True), sink)
    p = jnp.exp(s - m)
    return p / (jnp.sum(p, axis=-1, keepdims=True) + jnp.exp(sink - m))


def banded_window_attention(q, k, v, sinks):
    B, T = q.shape[:2]
    nc = T // CHUNK
    qc = q.reshape(B, nc, CHUNK, N_KV_HEADS, Q_GROUP, HEAD_DIM)
    pad = ((0, 0), (WIN_CHUNKS * CHUNK, 0), (0, 0), (0, 0))
    kp = jnp.pad(k, pad).reshape(B, nc + WIN_CHUNKS, CHUNK, N_KV_HEADS, HEAD_DIM)
    vp = jnp.pad(v, pad).reshape(B, nc + WIN_CHUNKS, CHUNK, N_KV_HEADS, HEAD_DIM)
    kb = jnp.concatenate([kp[:, j:j + nc] for j in range(WIN_CHUNKS + 1)], axis=2)
    vb = jnp.concatenate([vp[:, j:j + nc] for j in range(WIN_CHUNKS + 1)], axis=2)
    key_chunk = (jnp.arange(nc)[:, None] - WIN_CHUNKS
                 + jnp.repeat(jnp.arange(WIN_CHUNKS + 1), CHUNK)[None, :])
    valid = (key_chunk >= 0)[:, None, None, None, :]
    scores = jnp.einsum('bcqkgd,bcskd->bckgqs', qc, kb, preferred_element_type=jnp.float32) * ATT_SCALE
    p = sink_probs(scores, valid, sinks)
    out = jnp.einsum('bckgqs,bcskd->bcqkgd', p.astype(v.dtype), vb)
    return out.reshape(B, T, ATT_WIDTH)


def cached_window_attention(q, k, v, cache_k, cache_v, sinks):
    B, S = q.shape[:2]
    cw = cache_k.shape[1]
    kk = jnp.concatenate([cache_k.astype(k.dtype), k], axis=1)
    vv = jnp.concatenate([cache_v.astype(v.dtype), v], axis=1)
    q_pos = PAST_LEN + jnp.arange(S)
    k_pos = jnp.concatenate([PAST_LEN - cw + jnp.arange(cw), q_pos])
    qch = (q_pos // CHUNK)[:, None]
    kch = (k_pos // CHUNK)[None, :]
    valid = (kch <= qch) & (qch - kch <= WIN_CHUNKS) & (k_pos[None, :] >= 0)
    qg = q.reshape(B, S, N_KV_HEADS, Q_GROUP, HEAD_DIM)
    scores = jnp.einsum('bqkgd,bskd->bkgqs', qg, kk, preferred_element_type=jnp.float32) * ATT_SCALE
    p = sink_probs(scores, valid, sinks)
    out = jnp.einsum('bkgqs,bskd->bqkgd', p.astype(vv.dtype), vv)
    return out.reshape(B, S, ATT_WIDTH)


def layer(x, conv_prev, h0, attend, p):
    B, T = x.shape[:2]
    h = x + 0.5 * swiglu(rms_norm(x, p['norm_ff1']), p['ff1_gate'], p['ff1_up'], p['ff1_down'])
    u = rms_norm(h, p['norm_mix'])
    x_rnn, g_rnn, q, k, v, gate_r, gate_a = jnp.split(u @ p['w_in'], SPLIT_POINTS, axis=-1)
    conv_out, conv_state = causal_conv(x_rnn, conv_prev, p['conv_w'], p['conv_b'])
    lru_out, h_last = rg_lru(conv_out, h0, p['w_rg'], p['b_rg'], p['w_ig'], p['b_ig'], p['lru_lambda'])
    rec = jax.nn.gelu(g_rnn) * lru_out
    q = q.reshape(B, T, N_HEADS, HEAD_DIM)
    k = k.reshape(B, T, N_KV_HEADS, HEAD_DIM)
    v = v.reshape(B, T, N_KV_HEADS, HEAD_DIM)
    att = attend(q, k, v, p['attn_sinks'])
    branch_r = rec @ p['w_branch'][:D_RNN]
    branch_a = att @ p['w_branch'][D_RNN:]
    merged = jax.nn.sigmoid(gate_r) * branch_r + jax.nn.sigmoid(gate_a) * branch_a
    h = h + merged @ p['w_out']
    h = h + 0.5 * swiglu(rms_norm(h, p['norm_ff2']), p['ff2_gate'], p['ff2_up'], p['ff2_down'])
    return h, k, v, conv_state, h_last


def setup_inputs(seed: int = 0) -> dict:
    key = jax.random.key(seed)
    ks = jax.random.split(key, 32)
    f32 = jnp.float32
    cw = min(WINDOW, PAST_LEN)

    def nrm(k, shape, scale):
        return jax.random.normal(k, shape, f32) * scale

    a0 = jax.random.uniform(ks[20], (DEPTH, D_RNN), f32, minval=0.9, maxval=0.999)
    return {
        'x_prompt': nrm(ks[0], (BATCH, SEQ, D_MODEL), 1.0),
        'x_sample': nrm(ks[1], (DEC_BATCH, DEC_SEQ, D_MODEL), 1.0),
        'cache_k': nrm(ks[2], (DEPTH, DEC_BATCH, cw, N_KV_HEADS, HEAD_DIM), 1.0),
        'cache_v': nrm(ks[3], (DEPTH, DEC_BATCH, cw, N_KV_HEADS, HEAD_DIM), 1.0),
        'state_conv': nrm(ks[4], (DEPTH, DEC_BATCH, CONV_WIDTH - 1, D_RNN), 1.0),
        'state_lru': nrm(ks[5], (DEPTH, DEC_BATCH, D_RNN), 0.5),
        'norm_ff1': 1.0 + nrm(ks[6], (DEPTH, D_MODEL), 0.01),
        'ff1_gate': nrm(ks[7], (DEPTH, D_MODEL, D_FF), D_MODEL ** -0.5),
        'ff1_up': nrm(ks[8], (DEPTH, D_MODEL, D_FF), D_MODEL ** -0.5),
        'ff1_down': nrm(ks[9], (DEPTH, D_FF, D_MODEL), D_FF ** -0.5),
        'norm_mix': 1.0 + nrm(ks[10], (DEPTH, D_MODEL), 0.01),
        'w_in': nrm(ks[11], (DEPTH, D_MODEL, D_IN), D_MODEL ** -0.5),
        'conv_w': nrm(ks[12], (DEPTH, CONV_WIDTH, D_RNN), CONV_WIDTH ** -0.5),
        'conv_b': nrm(ks[13], (DEPTH, D_RNN), 0.01),
        'w_rg': nrm(ks[14], (DEPTH, N_LRU_BLOCKS, LRU_BLOCK, LRU_BLOCK), LRU_BLOCK ** -0.5),
        'b_rg': nrm(ks[15], (DEPTH, N_LRU_BLOCKS, LRU_BLOCK), 0.01),
        'w_ig': nrm(ks[16], (DEPTH, N_LRU_BLOCKS, LRU_BLOCK, LRU_BLOCK), LRU_BLOCK ** -0.5),
        'b_ig': nrm(ks[17], (DEPTH, N_LRU_BLOCKS, LRU_BLOCK), 0.01),
        'lru_lambda': jnp.log(a0) - jnp.log1p(-a0),
        'attn_sinks': nrm(ks[18], (DEPTH, N_HEADS), 0.5),
        'w_branch': nrm(ks[19], (DEPTH, D_RNN + ATT_WIDTH, D_MODEL), D_RNN ** -0.5),
        'w_out': nrm(ks[21], (DEPTH, D_MODEL, D_MODEL), D_MODEL ** -0.5),
        'norm_ff2': 1.0 + nrm(ks[22], (DEPTH, D_MODEL), 0.01),
        'ff2_gate': nrm(ks[23], (DEPTH, D_MODEL, D_FF), D_MODEL ** -0.5),
        'ff2_up': nrm(ks[24], (DEPTH, D_MODEL, D_FF), D_MODEL ** -0.5),
        'ff2_down': nrm(ks[25], (DEPTH, D_FF, D_MODEL), D_FF ** -0.5),
        'norm_final': 1.0 + nrm(ks[26], (D_MODEL,), 0.01),
    }


def reference(x_prompt, x_sample, cache_k, cache_v, state_conv, state_lru,
              norm_ff1, ff1_gate, ff1_up, ff1_down, norm_mix, w_in, conv_w, conv_b,
              w_rg, b_rg, w_ig, b_ig, lru_lambda, attn_sinks, w_branch, w_out,
              norm_ff2, ff2_gate, ff2_up, ff2_down, norm_final):
    hp, hs = x_prompt, x_sample
    kp_l, vp_l, cp_l, lp_l, ks_l, vs_l, cs_l, ls_l = [], [], [], [], [], [], [], []
    for l in range(DEPTH):
        p = {'norm_ff1': norm_ff1[l], 'ff1_gate': ff1_gate[l], 'ff1_up': ff1_up[l], 'ff1_down': ff1_down[l],
             'norm_mix': norm_mix[l], 'w_in': w_in[l], 'conv_w': conv_w[l], 'conv_b': conv_b[l],
             'w_rg': w_rg[l], 'b_rg': b_rg[l], 'w_ig': w_ig[l], 'b_ig': b_ig[l],
             'lru_lambda': lru_lambda[l], 'attn_sinks': attn_sinks[l], 'w_branch': w_branch[l],
             'w_out': w_out[l], 'norm_ff2': norm_ff2[l], 'ff2_gate': ff2_gate[l], 'ff2_up': ff2_up[l],
             'ff2_down': ff2_down[l]}
        conv0 = jnp.zeros((hp.shape[0], CONV_WIDTH - 1, D_RNN), hp.dtype)
        h0 = jnp.zeros((hp.shape[0], D_RNN), state_lru.dtype)
        hp, k_p, v_p, conv_p, lru_p = layer(hp, conv0, h0, banded_window_attention, p)
        kp_l.append(k_p[:, -WINDOW:])
        vp_l.append(v_p[:, -WINDOW:])
        cp_l.append(conv_p)
        lp_l.append(lru_p)
        ck, cv = cache_k[l], cache_v[l]
        attend_s = lambda q, k, v, s, ck=ck, cv=cv: cached_window_attention(q, k, v, ck, cv, s)
        hs, k_s, v_s, conv_s, lru_s = layer(hs, state_conv[l], state_lru[l], attend_s, p)
        ks_l.append(k_s)
        vs_l.append(v_s)
        cs_l.append(conv_s)
        ls_l.append(lru_s)
    y_prompt = rms_norm(hp, norm_final)
    y_sample = rms_norm(hs, norm_final)
    return (y_prompt, y_sample,
            jnp.stack(kp_l), jnp.stack(vp_l), jnp.stack(cp_l), jnp.stack(lp_l),
            jnp.stack(ks_l), jnp.stack(vs_l), jnp.stack(cs_l), jnp.stack(ls_l))
```

```cpp
#include <hip/hip_runtime.h>
#include <hip/hip_cooperative_groups.h>
#include <cstdio>
#include <cstdint>
namespace cg = cooperative_groups;
namespace pg8 {
#define PG8_LAS __attribute__((address_space(3)))
typedef unsigned short bf16_t;
typedef short bf16x8 __attribute__((ext_vector_type(8)));
typedef float f32x4 __attribute__((ext_vector_type(4)));
typedef unsigned u32x4 __attribute__((ext_vector_type(4)));
constexpr int BM = 256, BK = 64, HALF = 128, HTB = HALF * BK * 2  , STAGE_BYTES = 8 * HTB, NXCD = 8, WGM = 8;

__host__ __device__ __forceinline__ int lds_byte(int r, int c) { const int st = (r >> 4) * 2 + (c >> 5), rr = r & 15, cc = c & 31, ob = rr * 64 + cc * 2; return st * 1024 + (ob ^ (((ob >> 9) & 1) << 5)); }
__host__ __device__ __forceinline__ void stage_rc(int b, int& R, int& C) { const int st = b / 1024, sb = b % 1024, swz = sb ^ (((sb >> 9) & 1) << 5); R = (st >> 1) * 16 + swz / 64; C = (st & 1) * 32 + (swz % 64) / 2; }
__host__ __device__ __forceinline__ int perm32(int rho) { const int n = rho >> 4, i = rho & 15; return 8 * (i >> 2) + 4 * n + (i & 3); }

struct Unit { int pm, pn, ko, nt; };
struct Gemm { const bf16_t* A; const bf16_t* Bt; int M, N, K, ld; };

struct StaticOrder {
    int nM, nN, nwg, G, c;
    __host__ __device__ void init(int M, int N, int G_, int c_) { nM = M / BM; nN = N / BM; nwg = nM * nN; G = G_; c = c_; }
    __host__ __device__ bool next(int i, Unit& u) const {
        const long L = (long)i * G + c; if (L >= nwg) return false;
        int wgid = (int)L; { const int q = nwg / NXCD, r = nwg % NXCD, xcd = wgid % NXCD, off = wgid / NXCD; wgid = (xcd < r ? xcd * (q + 1) : r * (q + 1) + (xcd - r) * q) + off; }
        const int nig = WGM * nN, gid = wgid / nig, fm = gid * WGM, gsz = (nM - fm) < WGM ? (nM - fm) : WGM;
        u.pm = fm + ((wgid % nig) % gsz); u.pn = (wgid % nig) / gsz; u.ko = 0; u.nt = 0; return true;
    }
    __device__ __forceinline__ void a_ready(const Unit&) const {}
    __device__ __forceinline__ void done(const Unit&) const {}
};
__device__ __forceinline__ unsigned cvt_pk_bf16(float lo, float hi) { unsigned r; asm volatile("v_cvt_pk_bf16_f32 %0, %1, %2" : "=v"(r) : "v"(lo), "v"(hi)); return r; }
typedef float f32x2 __attribute__((ext_vector_type(2)));
template <class Epi, class Sched, bool ALIGN_EPI = false, bool SP2 = false>
__device__ __forceinline__ void gemm_phase(PG8_LAS unsigned char* lds, const Gemm g, const Sched& S, const Epi& E) {
    const int tid = threadIdx.x, wid = __builtin_amdgcn_readfirstlane(tid >> 6), lane = tid & 63, wr = wid >> 2, wc = wid & 3, fr = lane & 15, fq = lane >> 4;
    const int K = g.ld, nt0 = g.K / BK;
    unsigned voffA[2], voffB[2];
#pragma unroll
    for (int i = 0; i < 2; ++i) { int R, C; stage_rc(tid * 16 + i * 8192, R, C); const int Rb = Epi::PERM ? ((R & ~31) + perm32(R & 31)) : R;
        voffA[i] = (unsigned)(R * K + C) * 2u; voffB[i] = (unsigned)(Rb * K + C) * 2u; }
    const size_t kstep = (size_t)(BK * 2);
    const size_t hstep = (size_t)HALF * K * 2;
    const size_t tstep = 2 * hstep;
    const unsigned ldsw = (unsigned)wid * 1024u;
    const int aoff = lds_byte(wr * 64 + fr, fq * 8), boff = lds_byte(wc * 32 + fr, fq * 8);
#define PG8_SA(b, h) (((b) * 2 + (h)) * HTB)
#define PG8_SB(b, h) ((4 + (b) * 2 + (h)) * HTB)
#define PG8_STAGE(bufoff, gbase, voff) do { _Pragma("unroll") for (int _i = 0; _i < 2; ++_i) \
        __builtin_amdgcn_global_load_lds((const unsigned*)((const char*)(gbase) + (voff)[_i]), (PG8_LAS unsigned*)(lds + (bufoff) + ldsw + _i * 8192), 16, 0, 0); } while (0)
#define PG8_LDA(dst, b, h) do { _Pragma("unroll") for (int m = 0; m < 4; ++m) _Pragma("unroll") for (int k = 0; k < 2; ++k) dst[m][k] = *(const PG8_LAS bf16x8*)(lds + PG8_SA(b, h) + aoff + m * 2048 + k * 1024); } while (0)
#define PG8_LDB(dst, b, h) do { _Pragma("unroll") for (int n = 0; n < 2; ++n) _Pragma("unroll") for (int k = 0; k < 2; ++k) dst[n][k] = *(const PG8_LAS bf16x8*)(lds + PG8_SB(b, h) + boff + n * 2048 + k * 1024); } while (0)
#define PG8_MMA(ai, bj, At, Bt) do { __builtin_amdgcn_s_setprio(1); _Pragma("unroll") for (int m = 0; m < 4; ++m) _Pragma("unroll") for (int n = 0; n < 2; ++n) _Pragma("unroll") for (int k = 0; k < 2; ++k) \
        acc[ai][bj][m][n] = __builtin_amdgcn_mfma_f32_16x16x32_bf16(Bt[n][k], At[m][k], acc[ai][bj][m][n], 0, 0, 0); __builtin_amdgcn_s_setprio(0); } while (0)
#define PG8_WAIT_V(n) asm volatile("s_waitcnt vmcnt(" #n ")" ::: "memory")
#define PG8_WAIT_L(n) asm volatile("s_waitcnt lgkmcnt(" #n ")" ::: "memory")
#define PG8_BAR __builtin_amdgcn_s_barrier()
#define PG8_SCHED __builtin_amdgcn_sched_barrier(0)
    Unit cur, nxt; int ui = 0;
    if (!S.next(0, cur)) return;
    f32x4 acc[2][2][4][2];
#pragma unroll
    for (int a = 0; a < 2; ++a)
#pragma unroll
        for (int b = 0; b < 2; ++b)
#pragma unroll
            for (int m = 0; m < 4; ++m)
#pragma unroll
                for (int n = 0; n < 2; ++n) acc[a][b][m][n] = (f32x4){0.f, 0.f, 0.f, 0.f};
    bf16x8 At[4][2], B0[2][2], B1[2][2];
    const char* cA = (const char*)g.A + (size_t)cur.pm * tstep + (size_t)cur.ko * 2; const char* cB = (const char*)g.Bt + (size_t)cur.pn * tstep + (size_t)cur.ko * 2;
    S.a_ready(cur);
    if constexpr (SP2) {
        PG8_STAGE(PG8_SB(0, 0), cB, voffB); PG8_STAGE(PG8_SB(0, 1), cB + hstep, voffB); PG8_STAGE(PG8_SA(0, 0), cA, voffA); PG8_STAGE(PG8_SA(0, 1), cA + hstep, voffA);
        if (wr == 1) PG8_BAR;
        PG8_WAIT_V(2); PG8_BAR;
        PG8_STAGE(PG8_SB(1, 0), cB + kstep, voffB); PG8_STAGE(PG8_SA(1, 0), cA + kstep, voffA); PG8_STAGE(PG8_SB(1, 1), cB + hstep + kstep, voffB);
        PG8_WAIT_V(6); PG8_BAR;
    } else {
        PG8_STAGE(PG8_SB(0, 0), cB, voffB); PG8_STAGE(PG8_SA(0, 0), cA, voffA); PG8_STAGE(PG8_SB(0, 1), cB + hstep, voffB); PG8_STAGE(PG8_SA(0, 1), cA + hstep, voffA);
        if (wr == 1) PG8_BAR;
        PG8_WAIT_V(4); PG8_BAR;
        PG8_STAGE(PG8_SB(1, 0), cB + kstep, voffB); PG8_STAGE(PG8_SA(1, 0), cA + kstep, voffA); PG8_STAGE(PG8_SB(1, 1), cB + hstep + kstep, voffB);
        PG8_WAIT_V(6); PG8_BAR;
    }
    for (;;) {
        const bool has_next = S.next(ui + 1, nxt);
        const int nt = cur.nt ? cur.nt : nt0;
        const char* nA = has_next ? (const char*)g.A + (size_t)nxt.pm * tstep + (size_t)nxt.ko * 2 : cA; const char* nB = has_next ? (const char*)g.Bt + (size_t)nxt.pn * tstep + (size_t)nxt.ko * 2 : cB;
        for (int t = 0; t < nt; t += 2) {
            const bool last = (t == nt - 2);
            const char* a1 = cA + (size_t)(t + 1) * kstep;
            const char* a2 = last ? nA : cA + (size_t)(t + 2) * kstep; const char* b2 = last ? nB : cB + (size_t)(t + 2) * kstep;
            const char* a3 = a2 + kstep; const char* b3 = b2 + kstep;
            if (last && has_next) S.a_ready(nxt);
            if constexpr (SP2) {
            PG8_LDB(B0, 0, 0); PG8_LDB(B1, 0, 1); PG8_SCHED; PG8_LDA(At, 0, 0); PG8_STAGE(PG8_SA(1, 1), a1 + hstep, voffA);
            PG8_WAIT_V(8); PG8_WAIT_L(0); PG8_BAR; PG8_MMA(0, 0, At, B0); PG8_MMA(0, 1, At, B1); PG8_BAR; PG8_SCHED;
            PG8_LDA(At, 0, 1); PG8_STAGE(PG8_SB(0, 0), b2, voffB); PG8_STAGE(PG8_SB(0, 1), b2 + hstep, voffB); PG8_STAGE(PG8_SA(0, 0), a2, voffA);
            PG8_WAIT_V(8); PG8_WAIT_L(0); PG8_BAR; PG8_MMA(1, 0, At, B0); PG8_MMA(1, 1, At, B1); PG8_BAR; PG8_SCHED;
            PG8_LDB(B0, 1, 0); PG8_LDB(B1, 1, 1); PG8_SCHED; PG8_LDA(At, 1, 0); PG8_STAGE(PG8_SA(0, 1), a2 + hstep, voffA);
            PG8_WAIT_V(8); PG8_WAIT_L(0); PG8_BAR; PG8_MMA(0, 0, At, B0); PG8_MMA(0, 1, At, B1); PG8_BAR; PG8_SCHED;
            PG8_LDA(At, 1, 1); PG8_STAGE(PG8_SB(1, 0), b3, voffB); PG8_STAGE(PG8_SB(1, 1), b3 + hstep, voffB); PG8_STAGE(PG8_SA(1, 0), a3, voffA);
            PG8_WAIT_V(8); PG8_WAIT_L(0); PG8_BAR; PG8_MMA(1, 0, At, B0); PG8_MMA(1, 1, At, B1); PG8_BAR; PG8_SCHED;
            } else {
            PG8_LDB(B0, 0, 0); PG8_SCHED; PG8_LDA(At, 0, 0); PG8_STAGE(PG8_SA(1, 1), a1 + hstep, voffA);
            PG8_WAIT_L(8); PG8_BAR; PG8_WAIT_L(0); PG8_MMA(0, 0, At, B0); PG8_BAR; PG8_SCHED;
            PG8_LDB(B1, 0, 1); PG8_STAGE(PG8_SB(0, 0), b2, voffB);
            PG8_BAR; PG8_WAIT_L(0); PG8_MMA(0, 1, At, B1); PG8_BAR;
            PG8_LDA(At, 0, 1); PG8_STAGE(PG8_SA(0, 0), a2, voffA);
            PG8_BAR; PG8_WAIT_L(0); PG8_MMA(1, 0, At, B0); PG8_BAR; PG8_SCHED;
            PG8_STAGE(PG8_SB(0, 1), b2 + hstep, voffB);
            PG8_WAIT_V(6); PG8_BAR; PG8_MMA(1, 1, At, B1); PG8_BAR;
            PG8_LDB(B0, 1, 0); PG8_SCHED; PG8_LDA(At, 1, 0); PG8_STAGE(PG8_SA(0, 1), a2 + hstep, voffA);
            PG8_WAIT_L(8); PG8_BAR; PG8_WAIT_L(0); PG8_MMA(0, 0, At, B0); PG8_BAR; PG8_SCHED;
            PG8_LDB(B1, 1, 1); PG8_STAGE(PG8_SB(1, 0), b3, voffB);
            PG8_BAR; PG8_WAIT_L(0); PG8_MMA(0, 1, At, B1); PG8_BAR;
            PG8_LDA(At, 1, 1); PG8_STAGE(PG8_SA(1, 0), a3, voffA);
            PG8_BAR; PG8_WAIT_L(0); PG8_MMA(1, 0, At, B0); PG8_BAR; PG8_SCHED;
            PG8_STAGE(PG8_SB(1, 1), b3 + hstep, voffB);
            PG8_WAIT_V(6); PG8_BAR; PG8_MMA(1, 1, At, B1); PG8_BAR;
            }
        }
        if constexpr (ALIGN_EPI) { if (wr == 0) PG8_BAR; }
        if constexpr (!Epi::AFTER_DRAIN) { E(acc, cur, wr, wc, fr, fq);
#if defined(PROBE_EPI2)
            if constexpr (Epi::IDEMP) { asm volatile("" ::: "memory"); E(acc, cur, wr, wc, fr, fq); }
#endif
            S.done(cur); }
        if (!has_next) break;
#pragma unroll
        for (int a = 0; a < 2; ++a)
#pragma unroll
            for (int b = 0; b < 2; ++b)
#pragma unroll
                for (int m = 0; m < 4; ++m)
#pragma unroll
                    for (int n = 0; n < 2; ++n) acc[a][b][m][n] = (f32x4){0.f, 0.f, 0.f, 0.f};
        cur = nxt; cA = nA; cB = nB; ++ui;
        if constexpr (ALIGN_EPI) { if (wr == 1) PG8_BAR; }
    }
    PG8_WAIT_V(0);
    if constexpr (!ALIGN_EPI) { if (wr == 0) PG8_BAR; }
    PG8_BAR;
    if constexpr (Epi::AFTER_DRAIN) { E.fused(acc, cur, wr, wc, fr, fq, lds, wid, lane); S.done(cur); }
#undef PG8_SA
#undef PG8_SB
#undef PG8_STAGE
#undef PG8_LDA
#undef PG8_LDB
#undef PG8_MMA
#undef PG8_WAIT_V
#undef PG8_WAIT_L
#undef PG8_BAR
#undef PG8_SCHED
}
}

#define LAS __attribute__((address_space(3)))
typedef unsigned short bf16;
typedef float f32x4 __attribute__((ext_vector_type(4)));
typedef unsigned u32x4 __attribute__((ext_vector_type(4)));
typedef unsigned u32x2 __attribute__((ext_vector_type(2)));
typedef short bf16x8 __attribute__((ext_vector_type(8)));
typedef short s16x4 __attribute__((ext_vector_type(4)));

constexpr int DM = 1024, NB = 16, SEQ = 4096, MP = NB * SEQ, SBATCH = 32, SSEQ = 16, MS = SBATCH * SSEQ, MT = MP + MS;
constexpr int DFF = 2816, DIN = 5632, ZA_W = 3584, ZG_W = 2048;
constexpr int NKV = 4, HD = 64, CW = 128;
constexpr float EPS = 1e-6f;
constexpr int NWAVES = 8, NTHREADS = 512;
constexpr int N_PHASES = 10;

constexpr size_t O_YP = 0, O_YS = 67108864, O_KP = O_YS + 524288, O_VP = O_KP + 524288, O_CP = O_VP + 524288, O_LP = O_CP + 49152,
                 O_KS = O_LP + 16384, O_VS = O_KS + 131072, O_CS = O_VS + 131072, O_LS = O_CS + 98304, O_END = O_LS + 32768;
constexpr size_t MiB = 1u << 20;
constexpr size_t WS_WGU1 = 0, WS_WD1 = 11 * MiB, WS_WIN = 17 * MiB, WS_WBR = 28 * MiB, WS_WBA = 30 * MiB, WS_WOUT = 32 * MiB, WS_WGU2 = 34 * MiB, WS_WD2 = 45 * MiB,
                 WS_WRG = 51 * MiB, WS_WIG = 51 * MiB + 512 * 1024, WS_SS1 = 52 * MiB, WS_SS2 = 57 * MiB, WS_SS3 = 62 * MiB, WS_SS0 = 778 * MiB + 130 * MiB  ,
                 WS_A = 68 * MiB  , WS_B = 520 * MiB  , WS_C = 778 * MiB  , WS_CTL = 916 * MiB  , WS_PART = 920 * MiB  , WS_END = 944 * MiB;
constexpr size_t CTL_ZERO_BYTES = 65536;
constexpr int LDS_BARST = 144000;
constexpr size_t OUT_H1 = 0, OUT_REC = (size_t)MT * DM * 2;
static_assert(OUT_REC * 2 == (O_KP) * 4, "h1 + rec fill exactly y_prompt + y_sample");
static_assert((size_t)MT * ZA_W * 2 <= WS_B - WS_A && (size_t)MT * ZG_W * 2 <= WS_C - WS_B && WS_C + (size_t)MT * DM * 2 <= WS_END, "ws map");
static_assert((size_t)MT * 16 * 4 <= 5 * MiB, "ss");

constexpr int LDS_BYTES = 147456;

__device__ __forceinline__ unsigned pk2(float lo, float hi) { return pg8::cvt_pk_bf16(lo, hi); }
__device__ __forceinline__ float bflo(unsigned w) { return __uint_as_float(w << 16); }
__device__ __forceinline__ float bfhi(unsigned w) { return __uint_as_float(w & 0xffff0000u); }
__device__ __forceinline__ float sigm(float x) { return __builtin_amdgcn_rcpf(1.f + __expf(-x)); }
__device__ __forceinline__ float gelu_tanh(float x) { const float u = 1.5957691216057308f * (x + 0.044715f * x * x * x); return x * sigm(u); }
__device__ __forceinline__ float silu(float x) { return x * sigm(x); }
__device__ __forceinline__ float wave_sum(float v) {
#pragma unroll
    for (int o = 1; o < 64; o <<= 1) v += __shfl_xor(v, o);
    return v;
}
__device__ __forceinline__ float rowscale(const float* ss, int row) {
    const f32x4* p = (const f32x4*)(ss + (size_t)row * 16);
    const f32x4 a = p[0], b = p[1], c = p[2], d = p[3];
    const float s = (((a.x + a.y) + (a.z + a.w)) + ((b.x + b.y) + (b.z + b.w))) + (((c.x + c.y) + (c.z + c.w)) + ((d.x + d.y) + (d.z + d.w)));
    return rsqrtf(s * (1.f / 1024.f) + EPS);
}
#define LDS_WAIT() asm volatile("s_waitcnt lgkmcnt(0)" ::: "memory")

typedef pg8::Unit Unit;
__device__ __forceinline__ float rs_from_quarter(f32x4 q) { float s = (q.x + q.y) + (q.z + q.w); s += __shfl_xor(s, 16); s += __shfl_xor(s, 32); return rsqrtf(s * (1.f / 1024.f) + EPS); }
#define UNPK8(W_, LO_, HI_) do { const u32x4 w__ = (W_); LO_ = (f32x4){bflo(w__.x), bfhi(w__.x), bflo(w__.y), bfhi(w__.y)}; HI_ = (f32x4){bflo(w__.z), bfhi(w__.z), bflo(w__.w), bfhi(w__.w)}; } while (0)
#define PK8(W_, LO_, HI_) do { u32x4 w__; w__.x = pk2((LO_)[0], (LO_)[1]); w__.y = pk2((LO_)[2], (LO_)[3]); w__.z = pk2((HI_)[0], (HI_)[1]); w__.w = pk2((HI_)[2], (HI_)[3]); W_ = w__; } while (0)
template <bool SCALE> struct EpiSwiGLU {
    static constexpr bool PERM = true, AFTER_DRAIN = false, IDEMP = true; static constexpr int NST = 8;
    bf16* O; const float* ss;
    __device__ __forceinline__ void operator()(const f32x4 (&acc)[2][2][4][2], const Unit& u, int wr, int wc, int fr, int fq) const {
        const int row0 = u.pm * 256 + wr * 64 + fr, col = u.pn * 128 + wc * 32 + 8 * fq;
        f32x4 sq[2][4];
        if (SCALE) {
#pragma unroll
            for (int ai = 0; ai < 2; ++ai)
#pragma unroll
                for (int m = 0; m < 4; ++m) sq[ai][m] = *(const f32x4*)(ss + (size_t)(row0 + ai * 128 + m * 16) * 16 + 4 * fq);
        }
#pragma unroll
        for (int ai = 0; ai < 2; ++ai)
#pragma unroll
            for (int m = 0; m < 4; ++m) {
                const int row = row0 + ai * 128 + m * 16;
                float rs = 1.f; if (SCALE) rs = rs_from_quarter(sq[ai][m]);
                const f32x4 g0 = acc[ai][0][m][0] * rs, g1 = acc[ai][0][m][1] * rs, u0 = acc[ai][1][m][0] * rs, u1 = acc[ai][1][m][1] * rs;
                u32x4 w;
                w.x = pk2(silu(g0[0]) * u0[0], silu(g0[1]) * u0[1]); w.y = pk2(silu(g0[2]) * u0[2], silu(g0[3]) * u0[3]);
                w.z = pk2(silu(g1[0]) * u1[0], silu(g1[1]) * u1[1]); w.w = pk2(silu(g1[2]) * u1[2], silu(g1[3]) * u1[3]);
                *(u32x4*)(O + (size_t)row * DFF + col) = w;
            }
    }
};
template <bool RES_BF16, bool OUT_F32> struct EpiRes {
    static constexpr bool PERM = true, AFTER_DRAIN = false, IDEMP = true; static constexpr int NST = OUT_F32 ? 32 : 16;
    const void* res; const float* res_s;
    void* out; float* ss; float fac;
    __device__ __forceinline__ void operator()(const f32x4 (&acc)[2][2][4][2], const Unit& u, int wr, int wc, int fr, int fq) const {
        const int row0 = u.pm * 256 + wr * 64 + fr, col0 = u.pn * 256 + wc * 32 + 8 * fq;
#pragma unroll
        for (int ai = 0; ai < 2; ++ai) {
            u32x4 rw[2][4][2];
            if (RES_BF16) {
#pragma unroll
                for (int m = 0; m < 4; ++m)
#pragma unroll
                    for (int bj = 0; bj < 2; ++bj) rw[ai][m][bj] = *(const u32x4*)((const bf16*)res + (size_t)(row0 + ai * 128 + m * 16) * DM + col0 + bj * 128);
            }
            f32x4 rf[4][2][2];
            if (!RES_BF16) {
                const float* rbase = (u.pm < MP / 256) ? (const float*)res + (size_t)(row0 + ai * 128) * DM + col0 : res_s + (size_t)(row0 + ai * 128 - MP) * DM + col0;
#pragma unroll
                for (int m = 0; m < 4; ++m)
#pragma unroll
                    for (int bj = 0; bj < 2; ++bj) { rf[m][bj][0] = *(const f32x4*)(rbase + (size_t)m * 16 * DM + bj * 128); rf[m][bj][1] = *(const f32x4*)(rbase + (size_t)m * 16 * DM + bj * 128 + 4); }
            }
#pragma unroll
            for (int m = 0; m < 4; ++m) {
                const int row = row0 + ai * 128 + m * 16; float sq = 0.f;
#pragma unroll
                for (int bj = 0; bj < 2; ++bj) {
                    const int col = col0 + bj * 128; f32x4 r0, r1;
                    if (RES_BF16) { UNPK8(rw[ai][m][bj], r0, r1); } else { r0 = rf[m][bj][0]; r1 = rf[m][bj][1]; }
                    const f32x4 v0 = r0 + acc[ai][bj][m][0] * fac, v1 = r1 + acc[ai][bj][m][1] * fac;
                    sq += (v0[0] * v0[0] + v0[1] * v0[1]) + (v0[2] * v0[2] + v0[3] * v0[3]) + (v1[0] * v1[0] + v1[1] * v1[1]) + (v1[2] * v1[2] + v1[3] * v1[3]);
                    if (OUT_F32) { float* op = (float*)out + (size_t)row * DM + col; *(f32x4*)op = v0; *(f32x4*)(op + 4) = v1; }
                    else { u32x4 w; PK8(w, v0, v1); *(u32x4*)((bf16*)out + (size_t)row * DM + col) = w; }
                }
                sq += __shfl_xor(sq, 16); sq += __shfl_xor(sq, 32);
                if (fq == 0) ss[(size_t)row * 16 + u.pn * 4 + wc] = sq;
            }
        }
    }
};
struct EpiWin {
    static constexpr bool PERM = true, AFTER_DRAIN = false, IDEMP = true; static constexpr int NST = 16;
    bf16* zA; bf16* zG; const float* ss;
    __device__ __forceinline__ void operator()(const f32x4 (&acc)[2][2][4][2], const Unit& u, int wr, int wc, int fr, int fq) const {
        const int row0 = u.pm * 256 + wr * 64 + fr;
        const bool gate = (u.pn >= 14);
        bf16* base = gate ? zG : zA; const int ld = gate ? ZG_W : ZA_W;
        const int col0 = (gate ? (u.pn - 14) * 256 : u.pn * 256) + wc * 32 + 8 * fq;
        f32x4 sq[2][4];
#pragma unroll
        for (int ai = 0; ai < 2; ++ai)
#pragma unroll
            for (int m = 0; m < 4; ++m) sq[ai][m] = *(const f32x4*)(ss + (size_t)(row0 + ai * 128 + m * 16) * 16 + 4 * fq);
#pragma unroll
        for (int ai = 0; ai < 2; ++ai)
#pragma unroll
            for (int m = 0; m < 4; ++m) {
                const int row = row0 + ai * 128 + m * 16; const float rs = rs_from_quarter(sq[ai][m]);
#pragma unroll
                for (int bj = 0; bj < 2; ++bj) {
                    f32x4 v0 = acc[ai][bj][m][0] * rs, v1 = acc[ai][bj][m][1] * rs;
                    if (gate) { v0 = (f32x4){sigm(v0[0]), sigm(v0[1]), sigm(v0[2]), sigm(v0[3])}; v1 = (f32x4){sigm(v1[0]), sigm(v1[1]), sigm(v1[2]), sigm(v1[3])}; }
                    u32x4 w; PK8(w, v0, v1);
                    *(u32x4*)(base + (size_t)row * ld + col0 + bj * 128) = w;
                }
            }
    }
};
template <bool ADD> struct EpiBranch {
    static constexpr bool PERM = true, AFTER_DRAIN = false, IDEMP = !ADD; static constexpr int NST = 16;
    bf16* mg; const bf16* zG; int goff;
    __device__ __forceinline__ void operator()(const f32x4 (&acc)[2][2][4][2], const Unit& u, int wr, int wc, int fr, int fq) const {
        const int row0 = u.pm * 256 + wr * 64 + fr, col0 = u.pn * 256 + wc * 32 + 8 * fq;
#pragma unroll
        for (int ai = 0; ai < 2; ++ai) {
            u32x4 gw[4][2], tw[4][2];
#pragma unroll
            for (int m = 0; m < 4; ++m)
#pragma unroll
                for (int bj = 0; bj < 2; ++bj) {
                    const size_t row = (size_t)(row0 + ai * 128 + m * 16);
                    gw[m][bj] = *(const u32x4*)(zG + row * ZG_W + goff + col0 + bj * 128);
                    if (ADD) tw[m][bj] = *(const u32x4*)(mg + row * DM + col0 + bj * 128);
                }
#pragma unroll
            for (int m = 0; m < 4; ++m)
#pragma unroll
                for (int bj = 0; bj < 2; ++bj) {
                    const size_t row = (size_t)(row0 + ai * 128 + m * 16);
                    f32x4 g0, g1; UNPK8(gw[m][bj], g0, g1);
                    f32x4 v0 = acc[ai][bj][m][0] * g0, v1 = acc[ai][bj][m][1] * g1;
                    if (ADD) { f32x4 t0, t1; UNPK8(tw[m][bj], t0, t1); v0 += t0; v1 += t1; }
                    u32x4 w; PK8(w, v0, v1);
                    *(u32x4*)(mg + row * DM + col0 + bj * 128) = w;
                }
        }
    }
};

template <int NN, int NS, int KS> struct SplitOrder {
    int G, c;
    __device__ __forceinline__ bool next(int i, Unit& u) const {
        const int L = i * G + c; if (L >= 2 * NN * NS) return false;
        const int sl = L / (2 * NN), r = L % (2 * NN); u.pm = MP / 256 + r / NN; u.pn = r % NN; u.ko = sl * KS; u.nt = KS / 64; return true;
    }
    __device__ __forceinline__ void a_ready(const Unit&) const {}
    __device__ __forceinline__ void done(const Unit&) const {}
};
template <int NN, int KS> struct EpiPartial {
    static constexpr bool PERM = true, AFTER_DRAIN = false, IDEMP = true; static constexpr int NST = 32;
    f32x4* P;
    __device__ __forceinline__ void operator()(const f32x4 (&acc)[2][2][4][2], const Unit& u, int wr, int wc, int fr, int fq) const {
        const int tl = (u.pm - MP / 256) * NN + u.pn, sl = u.ko / KS;
        const int tid_ = ((wr * 4 + wc) * 4 + fq) * 16 + fr;
        f32x4* base = P + ((size_t)(sl * 2 * NN + tl) * 512 + tid_) * 32;
#pragma unroll
        for (int ai = 0; ai < 2; ++ai)
#pragma unroll
            for (int bj = 0; bj < 2; ++bj)
#pragma unroll
                for (int m = 0; m < 4; ++m)
#pragma unroll
                    for (int n = 0; n < 2; ++n) base[(((ai * 2 + bj) * 4 + m) * 2 + n)] = acc[ai][bj][m][n];
    }
};
template <int NN, int NS, int KS> struct ComboOrder {
    pg8::StaticOrder so; SplitOrder<NN, NS, KS> sp; int rounds;
    __device__ __forceinline__ bool next(int i, Unit& u) const { if (i < rounds) return so.next(i, u); return sp.next(i - rounds, u); }
    __device__ __forceinline__ void a_ready(const Unit&) const {}
    __device__ __forceinline__ void done(const Unit&) const {}
};
template <int NN, int KS> struct EpiResSplit {
    static constexpr bool PERM = true, AFTER_DRAIN = false, IDEMP = true; static constexpr int NST = 16;
    EpiRes<true, false> R; EpiPartial<NN, KS> Pp;
    __device__ __forceinline__ void operator()(const f32x4 (&acc)[2][2][4][2], const Unit& u, int wr, int wc, int fr, int fq) const { if (u.nt) Pp(acc, u, wr, wc, fr, fq); else R(acc, u, wr, wc, fr, fq); }
};
template <int NS>
__device__ __forceinline__ void splitk_fixup_res(const bf16* res, bf16* out, float* ss, float fac, const f32x4* P, int nN, int G, int wid_s) {
    const int lane = (int)__builtin_amdgcn_mbcnt_hi(~0u, __builtin_amdgcn_mbcnt_lo(~0u, 0u)), wid = wid_s, tid = wid * 64 + lane, wr = wid >> 2, wc = wid & 3, fr = lane & 15, fq = lane >> 4;
    const size_t sstride = (size_t)(2 * nN) * 512 * 32;
    for (int w = blockIdx.x; w < 2 * nN * 8; w += G) {
        const int tl = w >> 3, am = w & 7, pm = MP / 256 + tl / nN, pn = tl % nN;
        const f32x4* base = P + ((size_t)tl * 512 + tid) * 32;
        const int ai = am >> 2, m = am & 3, row = pm * 256 + ai * 128 + wr * 64 + m * 16 + fr; float sq = 0.f;
#pragma unroll 1
        for (int bn = 0; bn < 4; ++bn) {
            const int bj = bn >> 1, n = bn & 1, col = pn * 256 + bj * 128 + wc * 32 + 8 * fq + 4 * n;
            const f32x4* pj = base + (((ai * 2 + bj) * 4 + m) * 2 + n);
            const u32x2 rw = *(const u32x2*)(res + (size_t)row * DM + col);
            f32x4 part[NS];
#pragma unroll
            for (int sl = 0; sl < NS; ++sl) part[sl] = pj[(size_t)sl * sstride];
            f32x4 sum = part[0];
#pragma unroll
            for (int sl = 1; sl < NS; ++sl) sum += part[sl];
            const f32x4 v = (f32x4){bflo(rw.x), bfhi(rw.x), bflo(rw.y), bfhi(rw.y)} + sum * fac;
            sq += (v[0] * v[0] + v[1] * v[1]) + (v[2] * v[2] + v[3] * v[3]);
            u32x2 wv; wv.x = pk2(v[0], v[1]); wv.y = pk2(v[2], v[3]);
            *(u32x2*)(out + (size_t)row * DM + col) = wv;
        }
        sq += __shfl_xor(sq, 16); sq += __shfl_xor(sq, 32);
        if (fq == 0) ss[(size_t)row * 16 + pn * 4 + wc] = sq;
    }
}

struct Args { const float* in[27]; float* out; unsigned char* ws; int ph_lo, ph_hi, coop, pad; };
enum { I_XP = 0, I_XS, I_CK, I_CV, I_SCONV, I_SLRU, I_NFF1, I_F1G, I_F1U, I_F1D, I_NMIX, I_WIN, I_CONVW, I_CONVB, I_WRG, I_BRG, I_WIG, I_BIG, I_LAM, I_SINK, I_WBR, I_WOUT, I_NFF2, I_F2G, I_F2U, I_F2D, I_NFIN };

__device__ __forceinline__ void transpose_item(const float* W, int N, bf16* dst, int dpitch, const float* fold, LAS float* scr, int k0, int n0, int dst_row0, int dk0, int lane) {
    float tv[32];
#pragma unroll
    for (int i = 0; i < 32; ++i) tv[i] = W[(size_t)(k0 + 2 * i + (lane >> 5)) * N + n0 + (lane & 31)];
#pragma unroll
    for (int i = 0; i < 32; ++i) { const int kk = 2 * i + (lane >> 5); float v = tv[i]; if (fold) v *= fold[k0 + kk]; scr[kk * 33 + (lane & 31)] = v; }
    LDS_WAIT(); asm volatile("" ::: "memory");
    const int c = lane & 7;
#pragma unroll
    for (int j = 0; j < 4; ++j) { const int n = (lane >> 3) + 8 * j; const LAS float* s = scr + (8 * c) * 33 + n;
        u32x4 o; o.x = pk2(s[0 * 33], s[1 * 33]); o.y = pk2(s[2 * 33], s[3 * 33]); o.z = pk2(s[4 * 33], s[5 * 33]); o.w = pk2(s[6 * 33], s[7 * 33]);
        *(u32x4*)(dst + (size_t)(dst_row0 + n) * dpitch + dk0 + 8 * c) = o; }
    LDS_WAIT(); asm volatile("" ::: "memory");
}
#define TJOB(SRC, NN, KK, DST, FOLD, MODE) { constexpr int ni_ = ((KK) / 64) * ((NN) / 32); if (r < ni_) { constexpr int nblk_ = (NN) / 32; const int kb_ = r / nblk_, n0_ = (r % nblk_) * 32; \
        const int dr0_ = ((MODE) == 0) ? n0_ : (256 * (n0_ / 128) + (n0_ % 128) + ((MODE) == 2 ? 128 : 0)); transpose_item((SRC), (NN), (DST), (KK), (FOLD), scr, kb_ * 64, n0_, dr0_, kb_ * 64, lane); continue; } r -= ni_; }
__device__ __forceinline__ void p0_prologue(const Args& a, LAS unsigned char* lds, int G) {
    const int tid = threadIdx.x, lane = tid & 63, wave = tid >> 6;
    LAS float* scr = (LAS float*)(lds + wave * 16384);
    const int gw = blockIdx.x * NWAVES + wave, NGW = G * NWAVES;
    unsigned char* ws = a.ws;
    constexpr int NITEMS = 6 * 1408 + 2816 + 3 * 512 + 2 * 64;
    for (int it = gw; it < NITEMS; it += NGW) {
        int r = it;
        TJOB(a.in[I_F1G], DFF, DM, (bf16*)(ws + WS_WGU1), a.in[I_NFF1], 1)
        TJOB(a.in[I_F1U], DFF, DM, (bf16*)(ws + WS_WGU1), a.in[I_NFF1], 2)
        TJOB(a.in[I_F1D], DM, DFF, (bf16*)(ws + WS_WD1), (const float*)nullptr, 0)
        TJOB(a.in[I_WIN], DIN, DM, (bf16*)(ws + WS_WIN), a.in[I_NMIX], 0)
        TJOB(a.in[I_WBR], DM, DM, (bf16*)(ws + WS_WBR), (const float*)nullptr, 0)
        TJOB(a.in[I_WBR] + (size_t)DM * DM, DM, DM, (bf16*)(ws + WS_WBA), (const float*)nullptr, 0)
        TJOB(a.in[I_WOUT], DM, DM, (bf16*)(ws + WS_WOUT), (const float*)nullptr, 0)
        TJOB(a.in[I_F2G], DFF, DM, (bf16*)(ws + WS_WGU2), a.in[I_NFF2], 1)
        TJOB(a.in[I_F2U], DFF, DM, (bf16*)(ws + WS_WGU2), a.in[I_NFF2], 2)
        TJOB(a.in[I_F2D], DM, DFF, (bf16*)(ws + WS_WD2), (const float*)nullptr, 0)
        { if (r < 64) { const int kb = r >> 2, n0 = (r & 3) * 32; transpose_item(a.in[I_WRG], 128, (bf16*)(ws + WS_WRG), 128, nullptr, scr, kb * 64, n0, (kb >> 1) * 128 + n0, (kb & 1) * 64, lane); continue; } r -= 64; }
        { const int kb = r >> 2, n0 = (r & 3) * 32; transpose_item(a.in[I_WIG], 128, (bf16*)(ws + WS_WIG), 128, nullptr, scr, kb * 64, n0, (kb >> 1) * 128 + n0, (kb & 1) * 64, lane); }
    }
    bf16* xn = (bf16*)(ws + WS_B);
    float* ss0 = (float*)(ws + WS_SS0);
    for (int m0 = gw; m0 < MT; m0 += 2 * NGW) {
        const int m1 = (m0 + NGW < MT) ? m0 + NGW : m0;
        const float* xr0 = (m0 < MP) ? a.in[I_XP] + (size_t)m0 * DM : a.in[I_XS] + (size_t)(m0 - MP) * DM;
        const float* xr1 = (m1 < MP) ? a.in[I_XP] + (size_t)m1 * DM : a.in[I_XS] + (size_t)(m1 - MP) * DM;
        f32x4 v0[4], v1[4]; float s0 = 0.f, s1 = 0.f;
#pragma unroll
        for (int j = 0; j < 4; ++j) { v0[j] = ((const f32x4*)xr0)[lane + 64 * j]; v1[j] = ((const f32x4*)xr1)[lane + 64 * j]; }
#pragma unroll
        for (int j = 0; j < 4; ++j) { s0 += (v0[j].x * v0[j].x + v0[j].y * v0[j].y) + (v0[j].z * v0[j].z + v0[j].w * v0[j].w); s1 += (v1[j].x * v1[j].x + v1[j].y * v1[j].y) + (v1[j].z * v1[j].z + v1[j].w * v1[j].w); }
        s0 = wave_sum(s0); s1 = wave_sum(s1);
        if (lane < 16) { ss0[(size_t)m0 * 16 + lane] = (lane == 0) ? s0 : 0.f; ss0[(size_t)m1 * 16 + lane] = (lane == 0) ? s1 : 0.f; }
        unsigned long long* o0 = (unsigned long long*)(xn + (size_t)m0 * DM) + lane; unsigned long long* o1 = (unsigned long long*)(xn + (size_t)m1 * DM) + lane;
#pragma unroll
        for (int j = 0; j < 4; ++j) {
            o0[64 * j] = (unsigned long long)pk2(v0[j].x, v0[j].y) | ((unsigned long long)pk2(v0[j].z, v0[j].w) << 32);
            o1[64 * j] = (unsigned long long)pk2(v1[j].x, v1[j].y) | ((unsigned long long)pk2(v1[j].z, v1[j].w) << 32); }
    }
}

constexpr int RC_CB = 0, RC_CF = 17408, RC_HS = 51200, RC_EX = 68608;
template <bool PROMPT>
__device__ __forceinline__ void rec_unit(const Args& a, LAS unsigned char* lds, const int b, const int cg) {
    const int tid = threadIdx.x, lane = tid & 63, wave = __builtin_amdgcn_readfirstlane(tid >> 6), fr = lane & 15, fq = lane >> 4, cgw = wave & 3, th = wave >> 2;
    const bf16* zA = (const bf16*)(a.ws + WS_A);
    bf16* rec = (bf16*)((unsigned char*)a.out + OUT_REC);
    LAS bf16* Cb = (LAS bf16*)(lds + RC_CB); LAS float* Hs = (LAS float*)(lds + RC_HS); LAS float* EX = (LAS float*)(lds + RC_EX);
    {
        constexpr int T = PROMPT ? SEQ : SSEQ;
        const int row0 = PROMPT ? b * SEQ : MP + b * SSEQ;
        const float* conv_prev = PROMPT ? nullptr : a.in[I_SCONV] + (size_t)b * 3 * DM;
        const float* h0 = PROMPT ? nullptr : a.in[I_SLRU] + (size_t)b * DM;
        float* o_conv = a.out + (PROMPT ? O_CP : O_CS) + (size_t)b * 3 * DM;
        float* o_lru = a.out + (PROMPT ? O_LP : O_LS) + (size_t)b * DM;
        const int n = cg >> 1;
        const int chl = cgw * 16 + fr, c = cg * 64 + chl, e = (cg & 1) * 64 + chl;
        bf16x8 Br[4], Bi[4];
        { const bf16* wr_ = (const bf16*)(a.ws + WS_WRG) + (size_t)n * 16384 + e * 128 + 8 * fq; const bf16* wi_ = (const bf16*)(a.ws + WS_WIG) + (size_t)n * 16384 + e * 128 + 8 * fq;
#pragma unroll
          for (int ks = 0; ks < 4; ++ks) { Br[ks] = *(const bf16x8*)(wr_ + 32 * ks); Bi[ks] = *(const bf16x8*)(wi_ + 32 * ks); } }
        const float bias_r = a.in[I_BRG][c], bias_i = a.in[I_BIG][c];
        const float lam = a.in[I_LAM][c];
        const float sp = (lam < 0.f) ? (-lam + log1pf(expf(lam))) : log1pf(expf(-lam));
        const float sp8l = -8.f * sp * 1.4426950408889634f;
        float h = h0 ? h0[c] : 0.f;
        const int cp2 = 2 * lane, cch = n * 128 + cp2, tg8 = 8 * wave;
        typedef float f32x2 __attribute__((ext_vector_type(2)));
        f32x2 cw2[4];
#pragma unroll
        for (int j = 0; j < 4; ++j) cw2[j] = *(const f32x2*)(a.in[I_CONVW] + j * DM + cch);
        const f32x2 cb2 = *(const f32x2*)(a.in[I_CONVB] + cch);
        const int nchunks = (T + 63) / 64;
        unsigned xq[11];
#define REC_LOADX(CK) do { const int tb_ = (CK) * 64 + tg8 - 3; \
            _Pragma("unroll") for (int rr = 0; rr < 11; ++rr) { int trc_ = tb_ + rr; trc_ = trc_ < 0 ? 0 : trc_; trc_ = trc_ > T - 1 ? T - 1 : trc_; \
                xq[rr] = *(const unsigned*)(zA + (size_t)(row0 + trc_) * ZA_W + cch); } \
            if (conv_prev && (CK) == 0 && wave == 0) { _Pragma("unroll") for (int rr = 0; rr < 3; ++rr) { const f32x2 pv_ = *(const f32x2*)(conv_prev + (size_t)rr * DM + cch); xq[rr] = pk2(pv_.x, pv_.y); } } } while (0)
        REC_LOADX(0);
        for (int ck = 0; ck < nchunks; ++ck) {
            const int t0 = ck * 64, nt = (T - t0) < 64 ? (T - t0) : 64;
            {
                f32x2 xv[11];
#pragma unroll
                for (int rr = 0; rr < 11; ++rr) { unsigned w = xq[rr]; if (t0 + tg8 - 3 + rr < 0 && !conv_prev) w = 0u; xv[rr] = (f32x2){bflo(w), bfhi(w)}; }
#pragma unroll
                for (int i = 0; i < 8; ++i) {
                    f32x2 cv = cb2;
#pragma unroll
                    for (int j = 0; j < 4; ++j) cv += xv[i + j] * cw2[j];
                    if (tg8 + i >= nt) cv = (f32x2){0.f, 0.f};
                    *(LAS unsigned*)(Cb + (tg8 + i) * 136 + cp2) = pk2(cv.x, cv.y);
                }
            }
            if (ck + 1 < nchunks) REC_LOADX(ck + 1);
            const u32x4 gq = *(const u32x4*)(zA + (size_t)(row0 + (((tid >> 3) < nt) ? t0 + (tid >> 3) : t0)) * ZA_W + 1024 + cg * 64 + (tid & 7) * 8);
            __syncthreads();
            float av[2][4], bv[2][4], segA[2], segH[2];
#pragma unroll
            for (int mtl = 0; mtl < 2; ++mtl) {
                const int mt = 2 * th + mtl;
                f32x4 dr = (f32x4){0.f, 0.f, 0.f, 0.f}, di = (f32x4){0.f, 0.f, 0.f, 0.f};
                if (16 * mt < nt) {
#pragma unroll
                    for (int ks = 0; ks < 4; ++ks) { const bf16x8 af = *(const LAS bf16x8*)(Cb + (16 * mt + fr) * 136 + 32 * ks + 8 * fq);
                        dr = __builtin_amdgcn_mfma_f32_16x16x32_bf16(af, Br[ks], dr, 0, 0, 0); di = __builtin_amdgcn_mfma_f32_16x16x32_bf16(af, Bi[ks], di, 0, 0, 0); }
                }
                float A = 1.f, H = 0.f;
#pragma unroll
                for (int jj = 0; jj < 4; ++jj) {
                    const int tk = 16 * mt + 4 * fq + jj; float aa = 1.f, bb = 0.f;
                    if (tk < nt) {
                        const float er = __builtin_amdgcn_exp2f(fminf((dr[jj] + bias_r) * -1.4426950408889634f, 60.f)), ei = __builtin_amdgcn_exp2f(fminf((di[jj] + bias_i) * -1.4426950408889634f, 60.f));
                        const float pr_ = 1.f + er, pi_ = 1.f + ei, rc = __builtin_amdgcn_rcpf(pr_ * pi_);
                        const float r = pi_ * rc, ig = pr_ * rc;
                        const float la2 = r * sp8l;
                        aa = __builtin_amdgcn_exp2f(la2);
                        const float y = la2 * 1.3862943611198906f;
                        const float om = (y > -0.1f) ? (-y * (1.f + y * (0.5f + y * ((1.f / 6.f) + y * ((1.f / 24.f) + y * (1.f / 120.f)))))) : (1.f - aa * aa);
                        bb = __builtin_amdgcn_sqrtf(om) * ig * __uint_as_float((unsigned)Cb[tk * 136 + e] << 16);
                    }
                    av[mtl][jj] = aa; bv[mtl][jj] = bb; H = aa * H + bb; A *= aa;
                }
                segA[mtl] = A; segH[mtl] = H;
            }
            float PA[2], PH[2], TA[2], TH[2];
#pragma unroll
            for (int mtl = 0; mtl < 2; ++mtl) {
                float pa = 1.f, ph = 0.f, ta = 1.f, tht = 0.f;
#pragma unroll
                for (int q = 0; q < 4; ++q) { const float Aq = __shfl(segA[mtl], fr + 16 * q), Hq = __shfl(segH[mtl], fr + 16 * q);
                    if (q < fq) { ph = Aq * ph + Hq; pa *= Aq; } tht = Aq * tht + Hq; ta *= Aq; }
                PA[mtl] = pa; PH[mtl] = ph; TA[mtl] = ta; TH[mtl] = tht;
            }
            const float WA = TA[0] * TA[1], WH = TA[1] * TH[0] + TH[1];
            PH[1] = PA[1] * TH[0] + PH[1]; PA[1] = TA[0] * PA[1];
            if (fq == 0) { EX[((th * 4 + cgw) * 16 + fr) * 2 + 0] = WA; EX[((th * 4 + cgw) * 16 + fr) * 2 + 1] = WH; }
            __syncthreads();
            const float WA0 = EX[((0 * 4 + cgw) * 16 + fr) * 2 + 0], WH0 = EX[((0 * 4 + cgw) * 16 + fr) * 2 + 1], WA1 = EX[((1 * 4 + cgw) * 16 + fr) * 2 + 0], WH1 = EX[((1 * 4 + cgw) * 16 + fr) * 2 + 1];
            const float hmid = WA0 * h + WH0, hend = WA1 * hmid + WH1;
            const float hst = (th == 0) ? h : hmid;
#pragma unroll
            for (int mtl = 0; mtl < 2; ++mtl) {
                const int mt = 2 * th + mtl; float hc = PA[mtl] * hst + PH[mtl];
#pragma unroll
                for (int jj = 0; jj < 4; ++jj) { hc = av[mtl][jj] * hc + bv[mtl][jj]; Hs[(16 * mt + 4 * fq + jj) * 68 + chl] = hc; }
            }
            h = hend;
            __syncthreads();
            { const int tk = tid >> 3, c8 = (tid & 7) * 8;
              if (tk < nt) {
                const size_t row = (size_t)(row0 + t0 + tk);
                const u32x4 gw = gq;
                const f32x4 h0v = *(const LAS f32x4*)(Hs + tk * 68 + c8), h1v = *(const LAS f32x4*)(Hs + tk * 68 + c8 + 4);
                u32x4 w; w.x = pk2(gelu_tanh(bflo(gw.x)) * h0v.x, gelu_tanh(bfhi(gw.x)) * h0v.y); w.y = pk2(gelu_tanh(bflo(gw.y)) * h0v.z, gelu_tanh(bfhi(gw.y)) * h0v.w);
                w.z = pk2(gelu_tanh(bflo(gw.z)) * h1v.x, gelu_tanh(bfhi(gw.z)) * h1v.y); w.w = pk2(gelu_tanh(bflo(gw.w)) * h1v.z, gelu_tanh(bfhi(gw.w)) * h1v.w);
                *(u32x4*)(rec + row * DM + cg * 64 + c8) = w;
              } }
        }
#undef REC_LOADX
        if (th == 0 && fq == 0) o_lru[c] = h;
        if (tid < 192) { const int j = tid >> 6, ch = tid & 63; const unsigned w = zA[(size_t)(row0 + T - 3 + j) * ZA_W + cg * 64 + ch]; o_conv[j * DM + cg * 64 + ch] = __uint_as_float(w << 16); }
        __syncthreads();
    }
}
__device__ __forceinline__ void rec_phase(const Args& a, LAS unsigned char* lds, int G) {
    for (int u = blockIdx.x; u < 768; u += G) { if (u < 256) rec_unit<true>(a, lds, u >> 4, u & 15); else rec_unit<false>(a, lds, (u - 256) >> 4, (u - 256) & 15); }
}
constexpr int AT_KS = 0, AT_VT = 27648;
template <int NBLK, bool FULL = false>
__device__ __forceinline__ void attn_block(bf16* att, LAS bf16* Ks, LAS bf16* Vt, size_t qrow0, int hh, float sink, const bf16x8 (&q)[2][2], unsigned vst_, unsigned vval_, int fr, int fq) {
    const unsigned vst = FULL ? 0xFFFu : vst_, vval = FULL ? 0xFFFu : vval_;
    f32x4 st[NBLK][12];
#pragma unroll
    for (int kt = 0; kt < 12; ++kt) {
#pragma unroll
        for (int bi = 0; bi < NBLK; ++bi) st[bi][kt] = (f32x4){0.f, 0.f, 0.f, 0.f};
        if ((vst >> kt) & 1u) {
            const bf16x8 k0 = *(const LAS bf16x8*)(Ks + (16 * kt + fr) * 72 + 8 * fq), k1 = *(const LAS bf16x8*)(Ks + (16 * kt + fr) * 72 + 32 + 8 * fq);
#pragma unroll
            for (int bi = 0; bi < NBLK; ++bi) { st[bi][kt] = __builtin_amdgcn_mfma_f32_16x16x32_bf16(k0, q[bi][0], st[bi][kt], 0, 0, 0); st[bi][kt] = __builtin_amdgcn_mfma_f32_16x16x32_bf16(k1, q[bi][1], st[bi][kt], 0, 0, 0); }
        }
        if (FULL && (kt & 3) == 3) __builtin_amdgcn_sched_barrier(0);
    }
    float rl[NBLK];
#pragma unroll
    for (int bi = 0; bi < NBLK; ++bi) {
        constexpr float CS = 0.125f * 1.4426950408889634f;
        float mx = -1e30f;
#pragma unroll
        for (int kt = 0; kt < 12; ++kt) if ((vval >> kt) & 1u) mx = fmaxf(mx, fmaxf(fmaxf(st[bi][kt][0], st[bi][kt][1]), fmaxf(st[bi][kt][2], st[bi][kt][3])));
        mx = fmaxf(mx, __shfl_xor(mx, 16)); mx = fmaxf(mx, __shfl_xor(mx, 32));
        const float sink2 = sink * 1.4426950408889634f;
        const float m2 = fmaxf(mx * CS, sink2), nm2 = -m2;
        float l = 0.f;
#pragma unroll
        for (int kt = 0; kt < 12; ++kt) {
            if ((vval >> kt) & 1u) { st[bi][kt] = (f32x4){__builtin_amdgcn_exp2f(fmaf(st[bi][kt][0], CS, nm2)), __builtin_amdgcn_exp2f(fmaf(st[bi][kt][1], CS, nm2)), __builtin_amdgcn_exp2f(fmaf(st[bi][kt][2], CS, nm2)), __builtin_amdgcn_exp2f(fmaf(st[bi][kt][3], CS, nm2))}; l += (st[bi][kt][0] + st[bi][kt][1]) + (st[bi][kt][2] + st[bi][kt][3]); }
            else st[bi][kt] = (f32x4){0.f, 0.f, 0.f, 0.f};
        }
        l += __shfl_xor(l, 16); l += __shfl_xor(l, 32); l += __builtin_amdgcn_exp2f(sink2 - m2);
        rl[bi] = 1.f / l;
    }
    f32x4 o[NBLK][4];
#pragma unroll
    for (int bi = 0; bi < NBLK; ++bi)
#pragma unroll
        for (int dt = 0; dt < 4; ++dt) o[bi][dt] = (f32x4){0.f, 0.f, 0.f, 0.f};
#pragma unroll
    for (int kp = 0; kp < 6; ++kp) {
        if ((vst >> (2 * kp)) & 1u) {
            bf16x8 pf[NBLK];
#pragma unroll
            for (int bi = 0; bi < NBLK; ++bi) { u32x4 pw; pw.x = pk2(st[bi][2 * kp][0], st[bi][2 * kp][1]); pw.y = pk2(st[bi][2 * kp][2], st[bi][2 * kp][3]); pw.z = pk2(st[bi][2 * kp + 1][0], st[bi][2 * kp + 1][1]); pw.w = pk2(st[bi][2 * kp + 1][2], st[bi][2 * kp + 1][3]); pf[bi] = __builtin_bit_cast(bf16x8, pw); }
#pragma unroll
            for (int dt = 0; dt < 4; ++dt) {
                const u32x2 va = *(const LAS u32x2*)(Vt + (16 * dt + fr) * 200 + 32 * kp + 4 * fq), vb = *(const LAS u32x2*)(Vt + (16 * dt + fr) * 200 + 32 * kp + 16 + 4 * fq);
                const u32x4 vv = (u32x4){va.x, va.y, vb.x, vb.y};
#pragma unroll
                for (int bi = 0; bi < NBLK; ++bi) o[bi][dt] = __builtin_amdgcn_mfma_f32_16x16x32_bf16(__builtin_bit_cast(bf16x8, vv), pf[bi], o[bi][dt], 0, 0, 0);
            }
        }
        if (FULL) __builtin_amdgcn_sched_barrier(0);
    }
#pragma unroll
    for (int bi = 0; bi < NBLK; ++bi) {
        bf16* op = att + (qrow0 + 16 * bi) * DM + hh * 64 + 4 * fq;
#pragma unroll
        for (int dt = 0; dt < 4; ++dt) { u32x2 w; w.x = pk2(o[bi][dt][0] * rl[bi], o[bi][dt][1] * rl[bi]); w.y = pk2(o[bi][dt][2] * rl[bi], o[bi][dt][3] * rl[bi]); *(u32x2*)(op + 16 * dt) = w; }
    }
}
__device__ __forceinline__ void attn_store_piece(LAS bf16* Ks, LAS bf16* Vt, int r, int d8, u32x4 kw, u32x4 vw) {
    *(LAS u32x4*)(Ks + r * 72 + d8) = kw;
    Vt[(d8 + 0) * 200 + r] = (bf16)(vw.x & 0xffffu); Vt[(d8 + 1) * 200 + r] = (bf16)(vw.x >> 16);
    Vt[(d8 + 2) * 200 + r] = (bf16)(vw.y & 0xffffu); Vt[(d8 + 3) * 200 + r] = (bf16)(vw.y >> 16);
    Vt[(d8 + 4) * 200 + r] = (bf16)(vw.z & 0xffffu); Vt[(d8 + 5) * 200 + r] = (bf16)(vw.z >> 16);
    Vt[(d8 + 6) * 200 + r] = (bf16)(vw.w & 0xffffu); Vt[(d8 + 7) * 200 + r] = (bf16)(vw.w >> 16);
}
__device__ __forceinline__ void attn_phase(const Args& a, LAS unsigned char* lds, int G) {
    const int tid = threadIdx.x, lane = tid & 63, wave = __builtin_amdgcn_readfirstlane(tid >> 6), fr = lane & 15, fq = lane >> 4;
    const bf16* zA = (const bf16*)(a.ws + WS_A);
    bf16* att = (bf16*)(a.ws + WS_C);
    LAS bf16* Ks = (LAS bf16*)(lds + AT_KS); LAS bf16* Vt = (LAS bf16*)(lds + AT_VT);
    const float* sinks = a.in[I_SINK];
    for (int sg = blockIdx.x; sg < 256; sg += G) {
        const int bk = sg >> 2, b = bk >> 2, kvh = bk & 3, c0 = (sg & 3) * 16;
        const int r = tid >> 3, d8 = (tid & 7) * 8;
        const bf16* kbase = zA + ((size_t)b * SEQ + r) * ZA_W + 3072 + kvh * 64 + d8;
        for (int cc = c0 - 2; cc <= c0; ++cc) if (cc >= 0) {
            const u32x4 kw = *(const u32x4*)(kbase + (size_t)cc * 64 * ZA_W), vw = *(const u32x4*)(kbase + (size_t)cc * 64 * ZA_W + 256);
            attn_store_piece(Ks, Vt, (cc % 3) * 64 + r, d8, kw, vw);
        }
        __syncthreads();
        const int g = wave >> 1, hh = kvh * 4 + g; const float sink2 = sinks[hh] * 1.4426950408889634f;
        const bf16* qbase = zA + ((size_t)b * SEQ + (wave & 1) * 32 + fr) * ZA_W + 2048 + hh * 64 + 8 * fq;
        bf16x8 qf[2][2];
#pragma unroll
        for (int bi = 0; bi < 2; ++bi) { const bf16* qp = qbase + (size_t)(c0 * 64 + bi * 16) * ZA_W; qf[bi][0] = *(const bf16x8*)qp; qf[bi][1] = *(const bf16x8*)(qp + 32); }
        for (int c = c0; c < c0 + 16; ++c) {
            const bool more = (c + 1 < c0 + 16);
            u32x4 kw = (u32x4){0u, 0u, 0u, 0u}, vw = (u32x4){0u, 0u, 0u, 0u};
            bf16x8 qn[2][2];
#pragma unroll
            for (int bi = 0; bi < 2; ++bi) { qn[bi][0] = qf[bi][0]; qn[bi][1] = qf[bi][1]; }
            { const int cn = more ? c + 1 : c;
              kw = *(const u32x4*)(kbase + (size_t)cn * 64 * ZA_W); vw = *(const u32x4*)(kbase + (size_t)cn * 64 * ZA_W + 256);
#pragma unroll
              for (int bi = 0; bi < 2; ++bi) { const bf16* qp = qbase + (size_t)(cn * 64 + bi * 16) * ZA_W; qn[bi][0] = *(const bf16x8*)qp; qn[bi][1] = *(const bf16x8*)(qp + 32); } }
            unsigned vm = 0xFu << (4 * (c % 3));
            if (c >= 1) vm |= 0xFu << (4 * ((c - 1) % 3));
            if (c >= 2) vm |= 0xFu << (4 * ((c - 2) % 3));
            if (c >= 2) attn_block<2, true>(att, Ks, Vt, (size_t)b * SEQ + c * 64 + (wave & 1) * 32 + fr, hh, sink2 * 0.6931471805599453f, qf, 0xFFFu, 0xFFFu, fr, fq);
            else attn_block<2, false>(att, Ks, Vt, (size_t)b * SEQ + c * 64 + (wave & 1) * 32 + fr, hh, sink2 * 0.6931471805599453f, qf, vm, vm, fr, fq);
#pragma unroll
            for (int bi = 0; bi < 2; ++bi) { qf[bi][0] = qn[bi][0]; qf[bi][1] = qn[bi][1]; }
            __syncthreads();
            if (more) attn_store_piece(Ks, Vt, ((c + 1) % 3) * 64 + r, d8, kw, vw);
            __syncthreads();
        }
    }
    for (int us = blockIdx.x; us < 128; us += G) {
        const int b = us >> 2, kvh = us & 3;
#pragma unroll
        for (int i = 0; i < 3; ++i) {
            const int idx = tid + 512 * i, r = idx >> 3, d8 = (idx & 7) * 8;
            if (r < 160) {
                u32x4 kw, vw;
                if (r < CW) { const float* kp = a.in[I_CK] + ((size_t)(b * CW + r) * NKV + kvh) * HD + d8; const float* vp = a.in[I_CV] + ((size_t)(b * CW + r) * NKV + kvh) * HD + d8;
                    const f32x4 k0 = *(const f32x4*)kp, k1 = *(const f32x4*)(kp + 4), v0 = *(const f32x4*)vp, v1 = *(const f32x4*)(vp + 4);
                    kw.x = pk2(k0.x, k0.y); kw.y = pk2(k0.z, k0.w); kw.z = pk2(k1.x, k1.y); kw.w = pk2(k1.z, k1.w);
                    vw.x = pk2(v0.x, v0.y); vw.y = pk2(v0.z, v0.w); vw.z = pk2(v1.x, v1.y); vw.w = pk2(v1.z, v1.w); }
                else if (r < CW + SSEQ) { const size_t grow = (size_t)MP + (size_t)b * SSEQ + (r - CW);
                    kw = *(const u32x4*)(zA + grow * ZA_W + 3072 + kvh * 64 + d8); vw = *(const u32x4*)(zA + grow * ZA_W + 3328 + kvh * 64 + d8); }
                else { kw = (u32x4){0u, 0u, 0u, 0u}; vw = (u32x4){0u, 0u, 0u, 0u}; }
                attn_store_piece(Ks, Vt, r, d8, kw, vw);
            }
        }
        __syncthreads();
        if (wave < 4) { const int hh = kvh * 4 + wave; const size_t qrow = (size_t)MP + b * SSEQ + fr; const bf16* qp = zA + qrow * ZA_W + 2048 + hh * 64 + 8 * fq;
            bf16x8 qs[2][2]; qs[0][0] = *(const bf16x8*)qp; qs[0][1] = *(const bf16x8*)(qp + 32); qs[1][0] = qs[0][0]; qs[1][1] = qs[0][1];
            attn_block<1>(att, Ks, Vt, qrow, hh, sinks[hh], qs, 0x3FFu, 0x1FFu, fr, fq); }
        __syncthreads();
    }
}
__device__ __forceinline__ void kv_out_phase(const Args& a, int G) {
    const bf16* zA = (const bf16*)(a.ws + WS_A);
    const int gt = blockIdx.x * NTHREADS + threadIdx.x, NGT = G * NTHREADS;
    constexpr int NP = NB * CW * 64, NS = MS * 64;
    for (int i = gt; i < NP + NS; i += NGT) {
        int row_src; float* dst; int col;
        if (i < NP) { const int r = i >> 6; col = (i & 63) * 8; const int b = r >> 7, w = r & 127; row_src = b * SEQ + SEQ - CW + w; dst = a.out + ((col < 256) ? O_KP : O_VP) + (size_t)r * 256 + (col & 255); }
        else { const int j = i - NP; const int r = j >> 6; col = (j & 63) * 8; row_src = MP + r; dst = a.out + ((col < 256) ? O_KS : O_VS) + (size_t)r * 256 + (col & 255); }
        const u32x4 w = *(const u32x4*)(zA + (size_t)row_src * ZA_W + 3072 + col);
        *(f32x4*)dst = (f32x4){bflo(w.x), bfhi(w.x), bflo(w.y), bfhi(w.y)}; *(f32x4*)(dst + 4) = (f32x4){bflo(w.z), bfhi(w.z), bflo(w.w), bfhi(w.w)};
    }
}
__device__ __forceinline__ void final_phase(const Args& a, int G) {
    const int tid = threadIdx.x, lane = tid & 63, wave = tid >> 6;
    const int gw = blockIdx.x * NWAVES + wave, NGW = G * NWAVES;
    const float* ss = (const float*)(a.ws + WS_SS3);
    const bf16* h3 = (const bf16*)(a.ws + WS_B);
    const f32x4* g4 = (const f32x4*)a.in[I_NFIN];
    const f32x4 ga0 = g4[2 * lane], ga1 = g4[2 * lane + 1], gb0 = g4[128 + 2 * lane], gb1 = g4[128 + 2 * lane + 1];
    for (int mb = gw; mb < MT; mb += 4 * NGW) {
        int mr[4]; u32x4 wa[4], wb[4]; float rs[4];
#pragma unroll
        for (int k = 0; k < 4; ++k) { mr[k] = (mb + k * NGW < MT) ? mb + k * NGW : mb; wa[k] = *(const u32x4*)(h3 + (size_t)mr[k] * DM + 8 * lane); wb[k] = *(const u32x4*)(h3 + (size_t)mr[k] * DM + 512 + 8 * lane); }
#pragma unroll
        for (int k = 0; k < 4; ++k) rs[k] = rowscale(ss, mr[k]);
#pragma unroll
        for (int k = 0; k < 4; ++k) {
            f32x4 a0, a1, b0, b1; UNPK8(wa[k], a0, a1); UNPK8(wb[k], b0, b1);
            f32x4* yr = (f32x4*)(a.out + (size_t)mr[k] * DM);
            __builtin_nontemporal_store(a0 * rs[k] * ga0, &yr[2 * lane]); __builtin_nontemporal_store(a1 * rs[k] * ga1, &yr[2 * lane + 1]);
            __builtin_nontemporal_store(b0 * rs[k] * gb0, &yr[128 + 2 * lane]); __builtin_nontemporal_store(b1 * rs[k] * gb1, &yr[128 + 2 * lane + 1]);
        }
    }
}

#define XB_TMO      128
#define XB_XCNT(j)  (256  + 64 * (j))
#define XB_XSUB(j)  (1280 + 64 * (j))
#define XB_XGEN(j)  (2304 + 64 * (j))
#define XB_TOP      3328
#define XB_TOPGEN   3392
#define XCD_BAR_WORDS 3456
#define XB_SPIN_CAP (1u << 18)

__device__ __forceinline__ unsigned xb_ld(unsigned* p)              { return __hip_atomic_load(p, __ATOMIC_RELAXED, __HIP_MEMORY_SCOPE_AGENT); }
__device__ __forceinline__ unsigned xb_add(unsigned* p, unsigned v) { return __hip_atomic_fetch_add(p, v, __ATOMIC_RELAXED, __HIP_MEMORY_SCOPE_AGENT); }
__device__ __forceinline__ unsigned xb_xcc_id() { return (unsigned)__builtin_amdgcn_s_getreg((3 << 11) | 20) & 0xFu; }
#define XB_SPIN(cond, bar) do { unsigned _sp = 0; while (cond) { __builtin_amdgcn_s_sleep(1); \
    if ((++_sp & 255u) == 0u) { if (xb_ld(&(bar)[XB_TMO])) break; if (_sp > XB_SPIN_CAP) { atomicAdd(&(bar)[XB_TMO], 1u); break; } } } } while (0)

struct XcdBarrier {
    unsigned* bar; unsigned x;
    volatile LAS unsigned* st;
};

__device__ __forceinline__ XcdBarrier xcd_barrier_post(unsigned* bar, volatile LAS unsigned* st) {
    XcdBarrier b; b.bar = bar; b.x = xb_xcc_id(); b.st = st;
    if (threadIdx.x == 0) (void)xb_add(&bar[XB_XCNT(b.x)], 1u);
    return b;
}
__device__ __forceinline__ void xcd_barrier_complete(unsigned* bar, unsigned x, unsigned& nloc, unsigned& nx) {
    const unsigned G = gridDim.x * gridDim.y * gridDim.z;
    unsigned sum, cnt, mine, sp = 0u;
    for (;;) {
        sum = 0u; cnt = 0u; mine = 0u;
#pragma unroll
        for (unsigned j = 0; j < 16; ++j) { const unsigned c = xb_ld(&bar[XB_XCNT(j)]); sum += c; cnt += (c > 0u) ? 1u : 0u; mine = (j == x) ? c : mine; }
        if (sum == G) break;
        __builtin_amdgcn_s_sleep(1);
        if ((++sp & 255u) == 0u) { if (xb_ld(&bar[XB_TMO])) break; if (sp > XB_SPIN_CAP) { atomicAdd(&bar[XB_TMO], 1u); break; } }
    }
    nloc = mine > 0u ? mine : 1u; nx = cnt > 0u ? cnt : 1u;
}

__device__ __forceinline__ void xcd_barrier(const XcdBarrier& b) {
    asm volatile("s_waitcnt vmcnt(0)" ::: "memory");
    __syncthreads();
    if (threadIdx.x == 0) {
        unsigned* bar = b.bar;
        __builtin_amdgcn_s_waitcnt(0);
        unsigned nloc = b.st[0], nx = b.st[1];
        if (nloc == 0u) { xcd_barrier_complete(bar, b.x, nloc, nx); b.st[0] = nloc; b.st[1] = nx; }
        const unsigned old = xb_add(&bar[XB_XSUB(b.x)], 1u);
        const unsigned gen = old / nloc;
        if (old + 1u == (gen + 1u) * nloc) {
            __builtin_amdgcn_fence(__ATOMIC_RELEASE, "agent");
            asm volatile("s_waitcnt vmcnt(0)" ::: "memory");
            const unsigned og = xb_add(&bar[XB_TOP], 1u);
            const unsigned tg = og / nx;
            if (og + 1u == (tg + 1u) * nx) xb_add(&bar[XB_TOPGEN], 1u);
            else XB_SPIN(xb_ld(&bar[XB_TOPGEN]) == tg, bar);
            __builtin_amdgcn_fence(__ATOMIC_ACQUIRE, "agent");
            xb_add(&bar[XB_XGEN(b.x)], 1u);
            asm volatile("s_waitcnt vmcnt(0)" ::: "memory");
        } else {
            XB_SPIN(xb_ld(&bar[XB_XGEN(b.x)]) == gen, bar);
            __builtin_amdgcn_fence(__ATOMIC_ACQUIRE, "agent");
            asm volatile("s_waitcnt vmcnt(0)" ::: "memory");
        }
    }
    __syncthreads();
}

__global__ void __launch_bounds__(NTHREADS, 2) mk_fwd(Args a) {
    extern __shared__ __attribute__((aligned(16))) unsigned char lds_raw[];
    LAS unsigned char* lds = (LAS unsigned char*)lds_raw;
    const int G = gridDim.x, lo = a.ph_lo, hi = a.ph_hi;
    const int wid_k = __builtin_amdgcn_readfirstlane((int)(threadIdx.x >> 6));
    unsigned char* ws = a.ws;
#define IN(k) (lo <= (k) && (k) < hi)
#ifndef PROBE_DUP
#define PROBE_DUP 0
#endif
#define REP(k) for (int rep_ = 0; rep_ < (((PROBE_DUP) >> (k)) & 1) + 1; ++rep_)
    volatile LAS unsigned* barst = (volatile LAS unsigned*)(lds + LDS_BARST);
    if (threadIdx.x < 2) barst[threadIdx.x] = 0u;
    __syncthreads();
    XcdBarrier xbar; xbar.bar = (unsigned*)(ws + WS_CTL); xbar.x = 0; xbar.st = barst;
    if (a.coop) xbar = xcd_barrier_post((unsigned*)(ws + WS_CTL), barst);
#define SEAM(k) do { if (a.coop && IN(k) && IN((k) + 1)) { if (a.coop == 2) cg::this_grid().sync(); else xcd_barrier(xbar); } } while (0)
    typedef pg8::StaticOrder SO;
    bf16* h1 = (bf16*)((unsigned char*)a.out + OUT_H1);
    bf16* recb = (bf16*)((unsigned char*)a.out + OUT_REC);

    if (IN(0)) p0_prologue(a, lds, G);
    SEAM(0);
    if (IN(1)) {
        pg8::Gemm g{(const bf16*)(ws + WS_B), (const bf16*)(ws + WS_WGU1), MT, DIN, DM, DM}; SO S; S.init(MT, DIN, G, (int)blockIdx.x);
        EpiSwiGLU<true> E{(bf16*)(ws + WS_A), (const float*)(ws + WS_SS0)};
        pg8::gemm_phase<EpiSwiGLU<true>, SO, true, true>(lds, g, S, E);
    }
    SEAM(1);
    if (IN(2)) {
        pg8::Gemm g{(const bf16*)(ws + WS_A), (const bf16*)(ws + WS_WD1), MP, DM, DFF, DFF};
        typedef ComboOrder<DM / 256, DFF / 256, 256> CO; typedef EpiResSplit<DM / 256, 256> ERS;
        CO S; S.so.init(MP, DM, G, (int)blockIdx.x); S.sp.G = G; S.sp.c = (int)blockIdx.x; S.rounds = ((int)blockIdx.x < (MP / 256) * (DM / 256)) ? ((MP / 256) * (DM / 256) - (int)blockIdx.x + G - 1) / G : 0;
        ERS E{{(const bf16*)(ws + WS_B), nullptr, h1, (float*)(ws + WS_SS1), 0.5f}, {(f32x4*)(ws + WS_PART)}};
        pg8::gemm_phase<ERS, CO, true, true>(lds, g, S, E);
        if (a.coop) xcd_barrier(xbar);
        splitk_fixup_res<DFF / 256>((const bf16*)E.R.res, (bf16*)E.R.out, E.R.ss, 0.5f, (const f32x4*)(ws + WS_PART), DM / 256, G, wid_k);
    }
    SEAM(2);
    if (IN(3)) {
        pg8::Gemm g{h1, (const bf16*)(ws + WS_WIN), MT, DIN, DM, DM}; SO S; S.init(MT, DIN, G, (int)blockIdx.x);
        EpiWin E{(bf16*)(ws + WS_A), (bf16*)(ws + WS_B), (const float*)(ws + WS_SS1)};
        pg8::gemm_phase<EpiWin, SO, true, true>(lds, g, S, E);
    }
    SEAM(3);
    if (IN(4)) { REP(10) rec_phase(a, lds, G); REP(11) attn_phase(a, lds, G); kv_out_phase(a, G); }
    SEAM(4);
    if (IN(5)) {
        { pg8::Gemm g{recb, (const bf16*)(ws + WS_WBR), MT, DM, DM, DM}; SO S; S.init(MT, DM, G, (int)blockIdx.x);
          EpiBranch<false> E{(bf16*)(ws + WS_A), (const bf16*)(ws + WS_B), 0};
          pg8::gemm_phase<EpiBranch<false>, SO, true, true>(lds, g, S, E); }
        { pg8::Gemm g{(const bf16*)(ws + WS_C), (const bf16*)(ws + WS_WBA), MT, DM, DM, DM}; SO S; S.init(MT, DM, G, (int)blockIdx.x);
          EpiBranch<true> E{(bf16*)(ws + WS_A), (const bf16*)(ws + WS_B), 1024};
          pg8::gemm_phase<EpiBranch<true>, SO, true, true>(lds, g, S, E); }
    }
    SEAM(5);
    if (IN(6)) {
        pg8::Gemm g{(const bf16*)(ws + WS_A), (const bf16*)(ws + WS_WOUT), MT, DM, DM, DM}; SO S; S.init(MT, DM, G, (int)blockIdx.x);
        EpiRes<true, false> E{h1, nullptr, (bf16*)(ws + WS_B), (float*)(ws + WS_SS2), 1.0f};
        pg8::gemm_phase<EpiRes<true, false>, SO, true, true>(lds, g, S, E);
    }
    SEAM(6);
    if (IN(7)) {
        pg8::Gemm g{(const bf16*)(ws + WS_B), (const bf16*)(ws + WS_WGU2), MT, DIN, DM, DM}; SO S; S.init(MT, DIN, G, (int)blockIdx.x);
        EpiSwiGLU<true> E{(bf16*)(ws + WS_A), (const float*)(ws + WS_SS2)};
        pg8::gemm_phase<EpiSwiGLU<true>, SO, true, true>(lds, g, S, E);
    }
    SEAM(7);
    if (IN(8)) {
        pg8::Gemm g{(const bf16*)(ws + WS_A), (const bf16*)(ws + WS_WD2), MP, DM, DFF, DFF};
        typedef ComboOrder<DM / 256, DFF / 256, 256> CO; typedef EpiResSplit<DM / 256, 256> ERS;
        CO S; S.so.init(MP, DM, G, (int)blockIdx.x); S.sp.G = G; S.sp.c = (int)blockIdx.x; S.rounds = ((int)blockIdx.x < (MP / 256) * (DM / 256)) ? ((MP / 256) * (DM / 256) - (int)blockIdx.x + G - 1) / G : 0;
        ERS E{{(const bf16*)(ws + WS_B), nullptr, (bf16*)(ws + WS_B), (float*)(ws + WS_SS3), 0.5f}, {(f32x4*)(ws + WS_PART)}};
        pg8::gemm_phase<ERS, CO, true, true>(lds, g, S, E);
        if (a.coop) xcd_barrier(xbar);
        splitk_fixup_res<DFF / 256>((const bf16*)E.R.res, (bf16*)E.R.out, E.R.ss, 0.5f, (const f32x4*)(ws + WS_PART), DM / 256, G, wid_k);
    }
    SEAM(8);
    if (IN(9)) final_phase(a, G);
#undef IN
#undef SEAM
}

#ifndef MK_ONE_LAUNCH
#define MK_ONE_LAUNCH 1
#endif
extern "C" void kernel_launch(void* const* d_in, const int* in_sizes, int n_in, void* d_out, int out_size, void* d_ws, size_t ws_size, hipStream_t stream) {
    static int grid = 0;
    if (grid == 0) {
        if (n_in != 27 || in_sizes[0] != MP * DM || (size_t)out_size != O_END || ws_size < WS_END) {
            fprintf(stderr, "kernel_launch: unexpected shapes: n_in %d in0 %d out %d ws %zu (need %zu)\n", n_in, n_in > 0 ? in_sizes[0] : -1, out_size, ws_size, (size_t)WS_END); grid = -1; return; }
        int dev = 0, cus = 0, per_cu = 0;
        if (hipGetDevice(&dev) != hipSuccess || hipDeviceGetAttribute(&cus, hipDeviceAttributeMultiprocessorCount, dev) != hipSuccess) { grid = -1; return; }
        if (hipFuncSetAttribute((const void*)mk_fwd, hipFuncAttributeMaxDynamicSharedMemorySize, LDS_BYTES) != hipSuccess) { fprintf(stderr, "kernel_launch: hipFuncSetAttribute failed\n"); grid = -1; return; }
        if (hipOccupancyMaxActiveBlocksPerMultiprocessor(&per_cu, (const void*)mk_fwd, NTHREADS, LDS_BYTES) != hipSuccess || per_cu < 1) { fprintf(stderr, "kernel_launch: occupancy query gave %d\n", per_cu); per_cu = 1; }
        (void)hipGetLastError();
        grid = cus * per_cu;
        fprintf(stderr, "kernel_launch: grid %d (cus %d x %d)\n", grid, cus, per_cu);
    }
    if (grid < 0) return;
    Args a{};
    for (int i = 0; i < 27; ++i) a.in[i] = (const float*)d_in[i];
    a.out = (float*)d_out; a.ws = (unsigned char*)d_ws;
#if MK_ONE_LAUNCH
    if (hipMemsetAsync((char*)d_ws + WS_CTL, 0, CTL_ZERO_BYTES, stream) != hipSuccess) { fprintf(stderr, "kernel_launch: hipMemsetAsync failed\n"); return; }
    a.ph_lo = 0; a.ph_hi = N_PHASES; a.coop = 1;
    void* args[] = {&a};
    hipError_t e = hipLaunchCooperativeKernel((const void*)mk_fwd, dim3(grid), dim3(NTHREADS), args, LDS_BYTES, stream);
    if (e != hipSuccess) fprintf(stderr, "kernel_launch: cooperative launch failed: %s (grid %d)\n", hipGetErrorString(e), grid);
#else
    for (int p = 0; p < N_PHASES; ++p) {
        a.ph_lo = p; a.ph_hi = p + 1; a.coop = 0;
        hipLaunchKernelGGL(mk_fwd, dim3(grid), dim3(NTHREADS), LDS_BYTES, stream, a);
    }
#endif
}
```

```cpp
#include <hip/hip_runtime.h>
#include <hip/hip_cooperative_groups.h>
#include <cstdio>
#include <cstdint>
namespace cg = cooperative_groups;
namespace pg8 {
#define PG8_LAS __attribute__((address_space(3)))
typedef unsigned short bf16_t;
typedef short bf16x8 __attribute__((ext_vector_type(8)));
typedef float f32x4 __attribute__((ext_vector_type(4)));
typedef unsigned u32x4 __attribute__((ext_vector_type(4)));
constexpr int BM = 256, BK = 64, HALF = 128, HTB = HALF * BK * 2  , STAGE_BYTES = 8 * HTB, NXCD = 8, WGM = 8;

__host__ __device__ __forceinline__ int lds_byte(int r, int c) { const int st = (r >> 4) * 2 + (c >> 5), rr = r & 15, cc = c & 31, ob = rr * 64 + cc * 2; return st * 1024 + (ob ^ (((ob >> 9) & 1) << 5)); }
__host__ __device__ __forceinline__ void stage_rc(int b, int& R, int& C) { const int st = b / 1024, sb = b % 1024, swz = sb ^ (((sb >> 9) & 1) << 5); R = (st >> 1) * 16 + swz / 64; C = (st & 1) * 32 + (swz % 64) / 2; }
__host__ __device__ __forceinline__ int perm32(int rho) { const int n = rho >> 4, i = rho & 15; return 8 * (i >> 2) + 4 * n + (i & 3); }

struct Unit { int pm, pn, ko, nt; };
struct Gemm { const bf16_t* A; const bf16_t* Bt; int M, N, K, ld; };

struct StaticOrder {
    int nM, nN, nwg, G, c;
    __host__ __device__ void init(int M, int N, int G_, int c_) { nM = M / BM; nN = N / BM; nwg = nM * nN; G = G_; c = c_; }
    __host__ __device__ bool next(int i, Unit& u) const {
        const long L = (long)i * G + c; if (L >= nwg) return false;
        int wgid = (int)L; { const int q = nwg / NXCD, r = nwg % NXCD, xcd = wgid % NXCD, off = wgid / NXCD; wgid = (xcd < r ? xcd * (q + 1) : r * (q + 1) + (xcd - r) * q) + off; }
        const int nig = WGM * nN, gid = wgid / nig, fm = gid * WGM, gsz = (nM - fm) < WGM ? (nM - fm) : WGM;
        u.pm = fm + ((wgid % nig) % gsz); u.pn = (wgid % nig) / gsz; u.ko = 0; u.nt = 0; return true;
    }
    __device__ __forceinline__ void a_ready(const Unit&) const {}
    __device__ __forceinline__ void done(const Unit&) const {}
};
__device__ __forceinline__ unsigned cvt_pk_bf16(float lo, float hi) { unsigned r; asm volatile("v_cvt_pk_bf16_f32 %0, %1, %2" : "=v"(r) : "v"(lo), "v"(hi)); return r; }
typedef float f32x2 __attribute__((ext_vector_type(2)));
template <class Epi, class Sched, bool ALIGN_EPI = false, bool SP2 = false>
__device__ __forceinline__ void gemm_phase(PG8_LAS unsigned char* lds, const Gemm g, const Sched& S, const Epi& E) {
    const int tid = threadIdx.x, wid = __builtin_amdgcn_readfirstlane(tid >> 6), lane = tid & 63, wr = wid >> 2, wc = wid & 3, fr = lane & 15, fq = lane >> 4;
    const int K = g.ld, nt0 = g.K / BK;
    unsigned voffA[2], voffB[2];
#pragma unroll
    for (int i = 0; i < 2; ++i) { int R, C; stage_rc(tid * 16 + i * 8192, R, C); const int Rb = Epi::PERM ? ((R & ~31) + perm32(R & 31)) : R;
        voffA[i] = (unsigned)(R * K + C) * 2u; voffB[i] = (unsigned)(Rb * K + C) * 2u; }
    const size_t kstep = (size_t)(BK * 2);
    const size_t hstep = (size_t)HALF * K * 2;
    const size_t tstep = 2 * hstep;
    const unsigned ldsw = (unsigned)wid * 1024u;
    const int aoff = lds_byte(wr * 64 + fr, fq * 8), boff = lds_byte(wc * 32 + fr, fq * 8);
#define PG8_SA(b, h) (((b) * 2 + (h)) * HTB)
#define PG8_SB(b, h) ((4 + (b) * 2 + (h)) * HTB)
#define PG8_STAGE(bufoff, gbase, voff) do { _Pragma("unroll") for (int _i = 0; _i < 2; ++_i) \
        __builtin_amdgcn_global_load_lds((const unsigned*)((const char*)(gbase) + (voff)[_i]), (PG8_LAS unsigned*)(lds + (bufoff) + ldsw + _i * 8192), 16, 0, 0); } while (0)
#define PG8_LDA(dst, b, h) do { _Pragma("unroll") for (int m = 0; m < 4; ++m) _Pragma("unroll") for (int k = 0; k < 2; ++k) dst[m][k] = *(const PG8_LAS bf16x8*)(lds + PG8_SA(b, h) + aoff + m * 2048 + k * 1024); } while (0)
#define PG8_LDB(dst, b, h) do { _Pragma("unroll") for (int n = 0; n < 2; ++n) _Pragma("unroll") for (int k = 0; k < 2; ++k) dst[n][k] = *(const PG8_LAS bf16x8*)(lds + PG8_SB(b, h) + boff + n * 2048 + k * 1024); } while (0)
#define PG8_MMA(ai, bj, At, Bt) do { __builtin_amdgcn_s_setprio(1); _Pragma("unroll") for (int m = 0; m < 4; ++m) _Pragma("unroll") for (int n = 0; n < 2; ++n) _Pragma("unroll") for (int k = 0; k < 2; ++k) \
        acc[ai][bj][m][n] = __builtin_amdgcn_mfma_f32_16x16x32_bf16(Bt[n][k], At[m][k], acc[ai][bj][m][n], 0, 0, 0); __builtin_amdgcn_s_setprio(0); } while (0)
#define PG8_WAIT_V(n) asm volatile("s_waitcnt vmcnt(" #n ")" ::: "memory")
#define PG8_WAIT_L(n) asm volatile("s_waitcnt lgkmcnt(" #n ")" ::: "memory")
#define PG8_BAR __builtin_amdgcn_s_barrier()
#define PG8_SCHED __builtin_amdgcn_sched_barrier(0)
    Unit cur, nxt; int ui = 0;
    if (!S.next(0, cur)) return;
    f32x4 acc[2][2][4][2];
#pragma unroll
    for (int a = 0; a < 2; ++a)
#pragma unroll
        for (int b = 0; b < 2; ++b)
#pragma unroll
            for (int m = 0; m < 4; ++m)
#pragma unroll
                for (int n = 0; n < 2; ++n) acc[a][b][m][n] = (f32x4){0.f, 0.f, 0.f, 0.f};
    bf16x8 At[4][2], B0[2][2], B1[2][2];
    const char* cA = (const char*)g.A + (size_t)cur.pm * tstep + (size_t)cur.ko * 2; const char* cB = (const char*)g.Bt + (size_t)cur.pn * tstep + (size_t)cur.ko * 2;
    S.a_ready(cur);
    if constexpr (SP2) {
        PG8_STAGE(PG8_SB(0, 0), cB, voffB); PG8_STAGE(PG8_SB(0, 1), cB + hstep, voffB); PG8_STAGE(PG8_SA(0, 0), cA, voffA); PG8_STAGE(PG8_SA(0, 1), cA + hstep, voffA);
        if (wr == 1) PG8_BAR;
        PG8_WAIT_V(2); PG8_BAR;
        PG8_STAGE(PG8_SB(1, 0), cB + kstep, voffB); PG8_STAGE(PG8_SA(1, 0), cA + kstep, voffA); PG8_STAGE(PG8_SB(1, 1), cB + hstep + kstep, voffB);
        PG8_WAIT_V(6); PG8_BAR;
    } else {
        PG8_STAGE(PG8_SB(0, 0), cB, voffB); PG8_STAGE(PG8_SA(0, 0), cA, voffA); PG8_STAGE(PG8_SB(0, 1), cB + hstep, voffB); PG8_STAGE(PG8_SA(0, 1), cA + hstep, voffA);
        if (wr == 1) PG8_BAR;
        PG8_WAIT_V(4); PG8_BAR;
        PG8_STAGE(PG8_SB(1, 0), cB + kstep, voffB); PG8_STAGE(PG8_SA(1, 0), cA + kstep, voffA); PG8_STAGE(PG8_SB(1, 1), cB + hstep + kstep, voffB);
        PG8_WAIT_V(6); PG8_BAR;
    }
    for (;;) {
        const bool has_next = S.next(ui + 1, nxt);
        const int nt = cur.nt ? cur.nt : nt0;
        const char* nA = has_next ? (const char*)g.A + (size_t)nxt.pm * tstep + (size_t)nxt.ko * 2 : cA; const char* nB = has_next ? (const char*)g.Bt + (size_t)nxt.pn * tstep + (size_t)nxt.ko * 2 : cB;
        for (int t = 0; t < nt; t += 2) {
            const bool last = (t == nt - 2);
            const char* a1 = cA + (size_t)(t + 1) * kstep;
            const char* a2 = last ? nA : cA + (size_t)(t + 2) * kstep; const char* b2 = last ? nB : cB + (size_t)(t + 2) * kstep;
            const char* a3 = a2 + kstep; const char* b3 = b2 + kstep;
            if (last && has_next) S.a_ready(nxt);
            if constexpr (SP2) {
            PG8_LDB(B0, 0, 0); PG8_LDB(B1, 0, 1); PG8_SCHED; PG8_LDA(At, 0, 0); PG8_STAGE(PG8_SA(1, 1), a1 + hstep, voffA);
            PG8_WAIT_V(8); PG8_WAIT_L(0); PG8_BAR; PG8_MMA(0, 0, At, B0); PG8_MMA(0, 1, At, B1); PG8_BAR; PG8_SCHED;
            PG8_LDA(At, 0, 1); PG8_STAGE(PG8_SB(0, 0), b2, voffB); PG8_STAGE(PG8_SB(0, 1), b2 + hstep, voffB); PG8_STAGE(PG8_SA(0, 0), a2, voffA);
            PG8_WAIT_V(8); PG8_WAIT_L(0); PG8_BAR; PG8_MMA(1, 0, At, B0); PG8_MMA(1, 1, At, B1); PG8_BAR; PG8_SCHED;
            PG8_LDB(B0, 1, 0); PG8_LDB(B1, 1, 1); PG8_SCHED; PG8_LDA(At, 1, 0); PG8_STAGE(PG8_SA(0, 1), a2 + hstep, voffA);
            PG8_WAIT_V(8); PG8_WAIT_L(0); PG8_BAR; PG8_MMA(0, 0, At, B0); PG8_MMA(0, 1, At, B1); PG8_BAR; PG8_SCHED;
            PG8_LDA(At, 1, 1); PG8_STAGE(PG8_SB(1, 0), b3, voffB); PG8_STAGE(PG8_SB(1, 1), b3 + hstep, voffB); PG8_STAGE(PG8_SA(1, 0), a3, voffA);
            PG8_WAIT_V(8); PG8_WAIT_L(0); PG8_BAR; PG8_MMA(1, 0, At, B0); PG8_MMA(1, 1, At, B1); PG8_BAR; PG8_SCHED;
            } else {
            PG8_LDB(B0, 0, 0); PG8_SCHED; PG8_LDA(At, 0, 0); PG8_STAGE(PG8_SA(1, 1), a1 + hstep, voffA);
            PG8_WAIT_L(8); PG8_BAR; PG8_WAIT_L(0); PG8_MMA(0, 0, At, B0); PG8_BAR; PG8_SCHED;
            PG8_LDB(B1, 0, 1); PG8_STAGE(PG8_SB(0, 0), b2, voffB);
            PG8_BAR; PG8_WAIT_L(0); PG8_MMA(0, 1, At, B1); PG8_BAR;
            PG8_LDA(At, 0, 1); PG8_STAGE(PG8_SA(0, 0), a2, voffA);
            PG8_BAR; PG8_WAIT_L(0); PG8_MMA(1, 0, At, B0); PG8_BAR; PG8_SCHED;
            PG8_STAGE(PG8_SB(0, 1), b2 + hstep, voffB);
            PG8_WAIT_V(6); PG8_BAR; PG8_MMA(1, 1, At, B1); PG8_BAR;
            PG8_LDB(B0, 1, 0); PG8_SCHED; PG8_LDA(At, 1, 0); PG8_STAGE(PG8_SA(0, 1), a2 + hstep, voffA);
            PG8_WAIT_L(8); PG8_BAR; PG8_WAIT_L(0); PG8_MMA(0, 0, At, B0); PG8_BAR; PG8_SCHED;
            PG8_LDB(B1, 1, 1); PG8_STAGE(PG8_SB(1, 0), b3, voffB);
            PG8_BAR; PG8_WAIT_L(0); PG8_MMA(0, 1, At, B1); PG8_BAR;
            PG8_LDA(At, 1, 1); PG8_STAGE(PG8_SA(1, 0), a3, voffA);
            PG8_BAR; PG8_WAIT_L(0); PG8_MMA(1, 0, At, B0); PG8_BAR; PG8_SCHED;
            PG8_STAGE(PG8_SB(1, 1), b3 + hstep, voffB);
            PG8_WAIT_V(6); PG8_BAR; PG8_MMA(1, 1, At, B1); PG8_BAR;
            }
        }
        if constexpr (ALIGN_EPI) { if (wr == 0) PG8_BAR; }
        if constexpr (!Epi::AFTER_DRAIN) { E(acc, cur, wr, wc, fr, fq);
#if defined(PROBE_EPI2)
            if constexpr (Epi::IDEMP) { asm volatile("" ::: "memory"); E(acc, cur, wr, wc, fr, fq); }
#endif
            S.done(cur); }
        if (!has_next) break;
#pragma unroll
        for (int a = 0; a < 2; ++a)
#pragma unroll
            for (int b = 0; b < 2; ++b)
#pragma unroll
                for (int m = 0; m < 4; ++m)
#pragma unroll
                    for (int n = 0; n < 2; ++n) acc[a][b][m][n] = (f32x4){0.f, 0.f, 0.f, 0.f};
        cur = nxt; cA = nA; cB = nB; ++ui;
        if constexpr (ALIGN_EPI) { if (wr == 1) PG8_BAR; }
    }
    PG8_WAIT_V(0);
    if constexpr (!ALIGN_EPI) { if (wr == 0) PG8_BAR; }
    PG8_BAR;
    if constexpr (Epi::AFTER_DRAIN) { E.fused(acc, cur, wr, wc, fr, fq, lds, wid, lane); S.done(cur); }
#undef PG8_SA
#undef PG8_SB
#undef PG8_STAGE
#undef PG8_LDA
#undef PG8_LDB
#undef PG8_MMA
#undef PG8_WAIT_V
#undef PG8_WAIT_L
#undef PG8_BAR
#undef PG8_SCHED
}
}

#define LAS __attribute__((address_space(3)))
typedef unsigned short bf16;
typedef float f32x4 __attribute__((ext_vector_type(4)));
typedef unsigned u32x4 __attribute__((ext_vector_type(4)));
typedef unsigned u32x2 __attribute__((ext_vector_type(2)));
typedef short bf16x8 __attribute__((ext_vector_type(8)));
typedef short s16x4 __attribute__((ext_vector_type(4)));

constexpr int DM = 1024, NB = 16, SEQ = 4096, MP = NB * SEQ, SBATCH = 32, SSEQ = 16, MS = SBATCH * SSEQ, MT = MP + MS;
constexpr int DFF = 2816, DIN = 5632, ZA_W = 3584, ZG_W = 2048;
constexpr int NKV = 4, HD = 64, CW = 128;
constexpr float EPS = 1e-6f;
constexpr int NWAVES = 8, NTHREADS = 512;
constexpr int N_PHASES = 10;

constexpr size_t O_YP = 0, O_YS = 67108864, O_KP = O_YS + 524288, O_VP = O_KP + 524288, O_CP = O_VP + 524288, O_LP = O_CP + 49152,
                 O_KS = O_LP + 16384, O_VS = O_KS + 131072, O_CS = O_VS + 131072, O_LS = O_CS + 98304, O_END = O_LS + 32768;
constexpr size_t MiB = 1u << 20;
constexpr size_t WS_WGU1 = 0, WS_WD1 = 11 * MiB, WS_WIN = 17 * MiB, WS_WBR = 28 * MiB, WS_WBA = 30 * MiB, WS_WOUT = 32 * MiB, WS_WGU2 = 34 * MiB, WS_WD2 = 45 * MiB,
                 WS_WRG = 51 * MiB, WS_WIG = 51 * MiB + 512 * 1024, WS_SS1 = 52 * MiB, WS_SS2 = 57 * MiB, WS_SS3 = 62 * MiB, WS_SS0 = 778 * MiB + 130 * MiB  ,
                 WS_A = 68 * MiB  , WS_B = 520 * MiB  , WS_C = 778 * MiB  , WS_CTL = 916 * MiB  , WS_PART = 920 * MiB  , WS_END = 944 * MiB;
constexpr size_t CTL_ZERO_BYTES = 65536;
constexpr int LDS_BARST = 144000;
constexpr size_t OUT_H1 = 0, OUT_REC = (size_t)MT * DM * 2;
static_assert(OUT_REC * 2 == (O_KP) * 4, "h1 + rec fill exactly y_prompt + y_sample");
static_assert((size_t)MT * ZA_W * 2 <= WS_B - WS_A && (size_t)MT * ZG_W * 2 <= WS_C - WS_B && WS_C + (size_t)MT * DM * 2 <= WS_END, "ws map");
static_assert((size_t)MT * 16 * 4 <= 5 * MiB, "ss");

constexpr int LDS_BYTES = 147456;

__device__ __forceinline__ unsigned pk2(float lo, float hi) { return pg8::cvt_pk_bf16(lo, hi); }
__device__ __forceinline__ float bflo(unsigned w) { return __uint_as_float(w << 16); }
__device__ __forceinline__ float bfhi(unsigned w) { return __uint_as_float(w & 0xffff0000u); }
__device__ __forceinline__ float sigm(float x) { return __builtin_amdgcn_rcpf(1.f + __expf(-x)); }
__device__ __forceinline__ float gelu_tanh(float x) { const float u = 1.5957691216057308f * (x + 0.044715f * x * x * x); return x * sigm(u); }
__device__ __forceinline__ float silu(float x) { return x * sigm(x); }
__device__ __forceinline__ float wave_sum(float v) {
#pragma unroll
    for (int o = 1; o < 64; o <<= 1) v += __shfl_xor(v, o);
    return v;
}
__device__ __forceinline__ float rowscale(const float* ss, int row) {
    const f32x4* p = (const f32x4*)(ss + (size_t)row * 16);
    const f32x4 a = p[0], b = p[1], c = p[2], d = p[3];
    const float s = (((a.x + a.y) + (a.z + a.w)) + ((b.x + b.y) + (b.z + b.w))) + (((c.x + c.y) + (c.z + c.w)) + ((d.x + d.y) + (d.z + d.w)));
    return rsqrtf(s * (1.f / 1024.f) + EPS);
}
#define LDS_WAIT() asm volatile("s_waitcnt lgkmcnt(0)" ::: "memory")

typedef pg8::Unit Unit;
__device__ __forceinline__ float rs_from_quarter(f32x4 q) { float s = (q.x + q.y) + (q.z + q.w); s += __shfl_xor(s, 16); s += __shfl_xor(s, 32); return rsqrtf(s * (1.f / 1024.f) + EPS); }
#define UNPK8(W_, LO_, HI_) do { const u32x4 w__ = (W_); LO_ = (f32x4){bflo(w__.x), bfhi(w__.x), bflo(w__.y), bfhi(w__.y)}; HI_ = (f32x4){bflo(w__.z), bfhi(w__.z), bflo(w__.w), bfhi(w__.w)}; } while (0)
#define PK8(W_, LO_, HI_) do { u32x4 w__; w__.x = pk2((LO_)[0], (LO_)[1]); w__.y = pk2((LO_)[2], (LO_)[3]); w__.z = pk2((HI_)[0], (HI_)[1]); w__.w = pk2((HI_)[2], (HI_)[3]); W_ = w__; } while (0)
template <bool SCALE> struct EpiSwiGLU {
    static constexpr bool PERM = true, AFTER_DRAIN = false, IDEMP = true; static constexpr int NST = 8;
    bf16* O; const float* ss;
    __device__ __forceinline__ void operator()(const f32x4 (&acc)[2][2][4][2], const Unit& u, int wr, int wc, int fr, int fq) const {
        const int row0 = u.pm * 256 + wr * 64 + fr, col = u.pn * 128 + wc * 32 + 8 * fq;
        f32x4 sq[2][4];
        if (SCALE) {
#pragma unroll
            for (int ai = 0; ai < 2; ++ai)
#pragma unroll
                for (int m = 0; m < 4; ++m) sq[ai][m] = *(const f32x4*)(ss + (size_t)(row0 + ai * 128 + m * 16) * 16 + 4 * fq);
        }
#pragma unroll
        for (int ai = 0; ai < 2; ++ai)
#pragma unroll
            for (int m = 0; m < 4; ++m) {
                const int row = row0 + ai * 128 + m * 16;
                float rs = 1.f; if (SCALE) rs = rs_from_quarter(sq[ai][m]);
                const f32x4 g0 = acc[ai][0][m][0] * rs, g1 = acc[ai][0][m][1] * rs, u0 = acc[ai][1][m][0] * rs, u1 = acc[ai][1][m][1] * rs;
                u32x4 w;
                w.x = pk2(silu(g0[0]) * u0[0], silu(g0[1]) * u0[1]); w.y = pk2(silu(g0[2]) * u0[2], silu(g0[3]) * u0[3]);
                w.z = pk2(silu(g1[0]) * u1[0], silu(g1[1]) * u1[1]); w.w = pk2(silu(g1[2]) * u1[2], silu(g1[3]) * u1[3]);
                *(u32x4*)(O + (size_t)row * DFF + col) = w;
            }
    }
};
template <bool RES_BF16, bool OUT_F32> struct EpiRes {
    static constexpr bool PERM = true, AFTER_DRAIN = false, IDEMP = true; static constexpr int NST = OUT_F32 ? 32 : 16;
    const void* res; const float* res_s;
    void* out; float* ss; float fac;
    __device__ __forceinline__ void operator()(const f32x4 (&acc)[2][2][4][2], const Unit& u, int wr, int wc, int fr, int fq) const {
        const int row0 = u.pm * 256 + wr * 64 + fr, col0 = u.pn * 256 + wc * 32 + 8 * fq;
#pragma unroll
        for (int ai = 0; ai < 2; ++ai) {
            u32x4 rw[2][4][2];
            if (RES_BF16) {
#pragma unroll
                for (int m = 0; m < 4; ++m)
#pragma unroll
                    for (int bj = 0; bj < 2; ++bj) rw[ai][m][bj] = *(const u32x4*)((const bf16*)res + (size_t)(row0 + ai * 128 + m * 16) * DM + col0 + bj * 128);
            }
            f32x4 rf[4][2][2];
            if (!RES_BF16) {
                const float* rbase = (u.pm < MP / 256) ? (const float*)res + (size_t)(row0 + ai * 128) * DM + col0 : res_s + (size_t)(row0 + ai * 128 - MP) * DM + col0;
#pragma unroll
                for (int m = 0; m < 4; ++m)
#pragma unroll
                    for (int bj = 0; bj < 2; ++bj) { rf[m][bj][0] = *(const f32x4*)(rbase + (size_t)m * 16 * DM + bj * 128); rf[m][bj][1] = *(const f32x4*)(rbase + (size_t)m * 16 * DM + bj * 128 + 4); }
            }
#pragma unroll
            for (int m = 0; m < 4; ++m) {
                const int row = row0 + ai * 128 + m * 16; float sq = 0.f;
#pragma unroll
                for (int bj = 0; bj < 2; ++bj) {
                    const int col = col0 + bj * 128; f32x4 r0, r1;
                    if (RES_BF16) { UNPK8(rw[ai][m][bj], r0, r1); } else { r0 = rf[m][bj][0]; r1 = rf[m][bj][1]; }
                    const f32x4 v0 = r0 + acc[ai][bj][m][0] * fac, v1 = r1 + acc[ai][bj][m][1] * fac;
                    sq += (v0[0] * v0[0] + v0[1] * v0[1]) + (v0[2] * v0[2] + v0[3] * v0[3]) + (v1[0] * v1[0] + v1[1] * v1[1]) + (v1[2] * v1[2] + v1[3] * v1[3]);
                    if (OUT_F32) { float* op = (float*)out + (size_t)row * DM + col; *(f32x4*)op = v0; *(f32x4*)(op + 4) = v1; }
                    else { u32x4 w; PK8(w, v0, v1); *(u32x4*)((bf16*)out + (size_t)row * DM + col) = w; }
                }
                sq += __shfl_xor(sq, 16); sq += __shfl_xor(sq, 32);
                if (fq == 0) ss[(size_t)row * 16 + u.pn * 4 + wc] = sq;
            }
        }
    }
};
struct EpiWin {
    static constexpr bool PERM = true, AFTER_DRAIN = false, IDEMP = true; static constexpr int NST = 16;
    bf16* zA; bf16* zG; const float* ss;
    __device__ __forceinline__ void operator()(const f32x4 (&acc)[2][2][4][2], const Unit& u, int wr, int wc, int fr, int fq) const {
        const int row0 = u.pm * 256 + wr * 64 + fr;
        const bool gate = (u.pn >= 14);
        bf16* base = gate ? zG : zA; const int ld = gate ? ZG_W : ZA_W;
        const int col0 = (gate ? (u.pn - 14) * 256 : u.pn * 256) + wc * 32 + 8 * fq;
        f32x4 sq[2][4];
#pragma unroll
        for (int ai = 0; ai < 2; ++ai)
#pragma unroll
            for (int m = 0; m < 4; ++m) sq[ai][m] = *(const f32x4*)(ss + (size_t)(row0 + ai * 128 + m * 16) * 16 + 4 * fq);
#pragma unroll
        for (int ai = 0; ai < 2; ++ai)
#pragma unroll
            for (int m = 0; m < 4; ++m) {
                const int row = row0 + ai * 128 + m * 16; const float rs = rs_from_quarter(sq[ai][m]);
#pragma unroll
                for (int bj = 0; bj < 2; ++bj) {
                    f32x4 v0 = acc[ai][bj][m][0] * rs, v1 = acc[ai][bj][m][1] * rs;
                    if (gate) { v0 = (f32x4){sigm(v0[0]), sigm(v0[1]), sigm(v0[2]), sigm(v0[3])}; v1 = (f32x4){sigm(v1[0]), sigm(v1[1]), sigm(v1[2]), sigm(v1[3])}; }
                    u32x4 w; PK8(w, v0, v1);
                    *(u32x4*)(base + (size_t)row * ld + col0 + bj * 128) = w;
                }
            }
    }
};
template <bool ADD> struct EpiBranch {
    static constexpr bool PERM = true, AFTER_DRAIN = false, IDEMP = !ADD; static constexpr int NST = 16;
    bf16* mg; const bf16* zG; int goff;
    __device__ __forceinline__ void operator()(const f32x4 (&acc)[2][2][4][2], const Unit& u, int wr, int wc, int fr, int fq) const {
        const int row0 = u.pm * 256 + wr * 64 + fr, col0 = u.pn * 256 + wc * 32 + 8 * fq;
#pragma unroll
        for (int ai = 0; ai < 2; ++ai) {
            u32x4 gw[4][2], tw[4][2];
#pragma unroll
            for (int m = 0; m < 4; ++m)
#pragma unroll
                for (int bj = 0; bj < 2; ++bj) {
                    const size_t row = (size_t)(row0 + ai * 128 + m * 16);
                    gw[m][bj] = *(const u32x4*)(zG + row * ZG_W + goff + col0 + bj * 128);
                    if (ADD) tw[m][bj] = *(const u32x4*)(mg + row * DM + col0 + bj * 128);
                }
#pragma unroll
            for (int m = 0; m < 4; ++m)
#pragma unroll
                for (int bj = 0; bj < 2; ++bj) {
                    const size_t row = (size_t)(row0 + ai * 128 + m * 16);
                    f32x4 g0, g1; UNPK8(gw[m][bj], g0, g1);
                    f32x4 v0 = acc[ai][bj][m][0] * g0, v1 = acc[ai][bj][m][1] * g1;
                    if (ADD) { f32x4 t0, t1; UNPK8(tw[m][bj], t0, t1); v0 += t0; v1 += t1; }
                    u32x4 w; PK8(w, v0, v1);
                    *(u32x4*)(mg + row * DM + col0 + bj * 128) = w;
                }
        }
    }
};

template <int NN, int NS, int KS> struct SplitOrder {
    int G, c;
    __device__ __forceinline__ bool next(int i, Unit& u) const {
        const int L = i * G + c; if (L >= 2 * NN * NS) return false;
        const int sl = L / (2 * NN), r = L % (2 * NN); u.pm = MP / 256 + r / NN; u.pn = r % NN; u.ko = sl * KS; u.nt = KS / 64; return true;
    }
    __device__ __forceinline__ void a_ready(const Unit&) const {}
    __device__ __forceinline__ void done(const Unit&) const {}
};
template <int NN, int KS> struct EpiPartial {
    static constexpr bool PERM = true, AFTER_DRAIN = false, IDEMP = true; static constexpr int NST = 32;
    f32x4* P;
    __device__ __forceinline__ void operator()(const f32x4 (&acc)[2][2][4][2], const Unit& u, int wr, int wc, int fr, int fq) const {
        const int tl = (u.pm - MP / 256) * NN + u.pn, sl = u.ko / KS;
        const int tid_ = ((wr * 4 + wc) * 4 + fq) * 16 + fr;
        f32x4* base = P + ((size_t)(sl * 2 * NN + tl) * 512 + tid_) * 32;
#pragma unroll
        for (int ai = 0; ai < 2; ++ai)
#pragma unroll
            for (int bj = 0; bj < 2; ++bj)
#pragma unroll
                for (int m = 0; m < 4; ++m)
#pragma unroll
                    for (int n = 0; n < 2; ++n) base[(((ai * 2 + bj) * 4 + m) * 2 + n)] = acc[ai][bj][m][n];
    }
};
template <int NN, int NS, int KS> struct ComboOrder {
    pg8::StaticOrder so; SplitOrder<NN, NS, KS> sp; int rounds;
    __device__ __forceinline__ bool next(int i, Unit& u) const { if (i < rounds) return so.next(i, u); return sp.next(i - rounds, u); }
    __device__ __forceinline__ void a_ready(const Unit&) const {}
    __device__ __forceinline__ void done(const Unit&) const {}
};
template <int NN, int KS> struct EpiResSplit {
    static constexpr bool PERM = true, AFTER_DRAIN = false, IDEMP = true; static constexpr int NST = 16;
    EpiRes<true, false> R; EpiPartial<NN, KS> Pp;
    __device__ __forceinline__ void operator()(const f32x4 (&acc)[2][2][4][2], const Unit& u, int wr, int wc, int fr, int fq) const { if (u.nt) Pp(acc, u, wr, wc, fr, fq); else R(acc, u, wr, wc, fr, fq); }
};
template <int NS>
__device__ __forceinline__ void splitk_fixup_res(const bf16* res, bf16* out, float* ss, float fac, const f32x4* P, int nN, int G, int wid_s) {
    const int lane = (int)__builtin_amdgcn_mbcnt_hi(~0u, __builtin_amdgcn_mbcnt_lo(~0u, 0u)), wid = wid_s, tid = wid * 64 + lane, wr = wid >> 2, wc = wid & 3, fr = lane & 15, fq = lane >> 4;
    const size_t sstride = (size_t)(2 * nN) * 512 * 32;
    for (int w = blockIdx.x; w < 2 * nN * 8; w += G) {
        const int tl = w >> 3, am = w & 7, pm = MP / 256 + tl / nN, pn = tl % nN;
        const f32x4* base = P + ((size_t)tl * 512 + tid) * 32;
        const int ai = am >> 2, m = am & 3, row = pm * 256 + ai * 128 + wr * 64 + m * 16 + fr; float sq = 0.f;
#pragma unroll 1
        for (int bn = 0; bn < 4; ++bn) {
            const int bj = bn >> 1, n = bn & 1, col = pn * 256 + bj * 128 + wc * 32 + 8 * fq + 4 * n;
            const f32x4* pj = base + (((ai * 2 + bj) * 4 + m) * 2 + n);
            const u32x2 rw = *(const u32x2*)(res + (size_t)row * DM + col);
            f32x4 part[NS];
#pragma unroll
            for (int sl = 0; sl < NS; ++sl) part[sl] = pj[(size_t)sl * sstride];
            f32x4 sum = part[0];
#pragma unroll
            for (int sl = 1; sl < NS; ++sl) sum += part[sl];
            const f32x4 v = (f32x4){bflo(rw.x), bfhi(rw.x), bflo(rw.y), bfhi(rw.y)} + sum * fac;
            sq += (v[0] * v[0] + v[1] * v[1]) + (v[2] * v[2] + v[3] * v[3]);
            u32x2 wv; wv.x = pk2(v[0], v[1]); wv.y = pk2(v[2], v[3]);
            *(u32x2*)(out + (size_t)row * DM + col) = wv;
        }
        sq += __shfl_xor(sq, 16); sq += __shfl_xor(sq, 32);
        if (fq == 0) ss[(size_t)row * 16 + pn * 4 + wc] = sq;
    }
}

struct Args { const float* in[27]; float* out; unsigned char* ws; int ph_lo, ph_hi, coop, pad; };
enum { I_XP = 0, I_XS, I_CK, I_CV, I_SCONV, I_SLRU, I_NFF1, I_F1G, I_F1U, I_F1D, I_NMIX, I_WIN, I_CONVW, I_CONVB, I_WRG, I_BRG, I_WIG, I_BIG, I_LAM, I_SINK, I_WBR, I_WOUT, I_NFF2, I_F2G, I_F2U, I_F2D, I_NFIN };

__device__ __forceinline__ void transpose_item(const float* W, int N, bf16* dst, int dpitch, const float* fold, LAS float* scr, int k0, int n0, int dst_row0, int dk0, int lane) {
    float tv[32];
#pragma unroll
    for (int i = 0; i < 32; ++i) tv[i] = W[(size_t)(k0 + 2 * i + (lane >> 5)) * N + n0 + (lane & 31)];
#pragma unroll
    for (int i = 0; i < 32; ++i) { const int kk = 2 * i + (lane >> 5); float v = tv[i]; if (fold) v *= fold[k0 + kk]; scr[kk * 33 + (lane & 31)] = v; }
    LDS_WAIT(); asm volatile("" ::: "memory");
    const int c = lane & 7;
#pragma unroll
    for (int j = 0; j < 4; ++j) { const int n = (lane >> 3) + 8 * j; const LAS float* s = scr + (8 * c) * 33 + n;
        u32x4 o; o.x = pk2(s[0 * 33], s[1 * 33]); o.y = pk2(s[2 * 33], s[3 * 33]); o.z = pk2(s[4 * 33], s[5 * 33]); o.w = pk2(s[6 * 33], s[7 * 33]);
        *(u32x4*)(dst + (size_t)(dst_row0 + n) * dpitch + dk0 + 8 * c) = o; }
    LDS_WAIT(); asm volatile("" ::: "memory");
}
#define TJOB(SRC, NN, KK, DST, FOLD, MODE) { constexpr int ni_ = ((KK) / 64) * ((NN) / 32); if (r < ni_) { constexpr int nblk_ = (NN) / 32; const int kb_ = r / nblk_, n0_ = (r % nblk_) * 32; \
        const int dr0_ = ((MODE) == 0) ? n0_ : (256 * (n0_ / 128) + (n0_ % 128) + ((MODE) == 2 ? 128 : 0)); transpose_item((SRC), (NN), (DST), (KK), (FOLD), scr, kb_ * 64, n0_, dr0_, kb_ * 64, lane); continue; } r -= ni_; }
__device__ __forceinline__ void p0_prologue(const Args& a, LAS unsigned char* lds, int G) {
    const int tid = threadIdx.x, lane = tid & 63, wave = tid >> 6;
    LAS float* scr = (LAS float*)(lds + wave * 16384);
    const int gw = blockIdx.x * NWAVES + wave, NGW = G * NWAVES;
    unsigned char* ws = a.ws;
    constexpr int NITEMS = 6 * 1408 + 2816 + 3 * 512 + 2 * 64;
    for (int it = gw; it < NITEMS; it += NGW) {
        int r = it;
        TJOB(a.in[I_F1G], DFF, DM, (bf16*)(ws + WS_WGU1), a.in[I_NFF1], 1)
        TJOB(a.in[I_F1U], DFF, DM, (bf16*)(ws + WS_WGU1), a.in[I_NFF1], 2)
        TJOB(a.in[I_F1D], DM, DFF, (bf16*)(ws + WS_WD1), (const float*)nullptr, 0)
        TJOB(a.in[I_WIN], DIN, DM, (bf16*)(ws + WS_WIN), a.in[I_NMIX], 0)
        TJOB(a.in[I_WBR], DM, DM, (bf16*)(ws + WS_WBR), (const float*)nullptr, 0)
        TJOB(a.in[I_WBR] + (size_t)DM * DM, DM, DM, (bf16*)(ws + WS_WBA), (const float*)nullptr, 0)
        TJOB(a.in[I_WOUT], DM, DM, (bf16*)(ws + WS_WOUT), (const float*)nullptr, 0)
        TJOB(a.in[I_F2G], DFF, DM, (bf16*)(ws + WS_WGU2), a.in[I_NFF2], 1)
        TJOB(a.in[I_F2U], DFF, DM, (bf16*)(ws + WS_WGU2), a.in[I_NFF2], 2)
        TJOB(a.in[I_F2D], DM, DFF, (bf16*)(ws + WS_WD2), (const float*)nullptr, 0)
        { if (r < 64) { const int kb = r >> 2, n0 = (r & 3) * 32; transpose_item(a.in[I_WRG], 128, (bf16*)(ws + WS_WRG), 128, nullptr, scr, kb * 64, n0, (kb >> 1) * 128 + n0, (kb & 1) * 64, lane); continue; } r -= 64; }
        { const int kb = r >> 2, n0 = (r & 3) * 32; transpose_item(a.in[I_WIG], 128, (bf16*)(ws + WS_WIG), 128, nullptr, scr, kb * 64, n0, (kb >> 1) * 128 + n0, (kb & 1) * 64, lane); }
    }
    bf16* xn = (bf16*)(ws + WS_B);
    float* ss0 = (float*)(ws + WS_SS0);
    for (int m0 = gw; m0 < MT; m0 += 2 * NGW) {
        const int m1 = (m0 + NGW < MT) ? m0 + NGW : m0;
        const float* xr0 = (m0 < MP) ? a.in[I_XP] + (size_t)m0 * DM : a.in[I_XS] + (size_t)(m0 - MP) * DM;
        const float* xr1 = (m1 < MP) ? a.in[I_XP] + (size_t)m1 * DM : a.in[I_XS] + (size_t)(m1 - MP) * DM;
        f32x4 v0[4], v1[4]; float s0 = 0.f, s1 = 0.f;
#pragma unroll
        for (int j = 0; j < 4; ++j) { v0[j] = ((const f32x4*)xr0)[lane + 64 * j]; v1[j] = ((const f32x4*)xr1)[lane + 64 * j]; }
#pragma unroll
        for (int j = 0; j < 4; ++j) { s0 += (v0[j].x * v0[j].x + v0[j].y * v0[j].y) + (v0[j].z * v0[j].z + v0[j].w * v0[j].w); s1 += (v1[j].x * v1[j].x + v1[j].y * v1[j].y) + (v1[j].z * v1[j].z + v1[j].w * v1[j].w); }
        s0 = wave_sum(s0); s1 = wave_sum(s1);
        if (lane < 16) { ss0[(size_t)m0 * 16 + lane] = (lane == 0) ? s0 : 0.f; ss0[(size_t)m1 * 16 + lane] = (lane == 0) ? s1 : 0.f; }
        unsigned long long* o0 = (unsigned long long*)(xn + (size_t)m0 * DM) + lane; unsigned long long* o1 = (unsigned long long*)(xn + (size_t)m1 * DM) + lane;
#pragma unroll
        for (int j = 0; j < 4; ++j) {
            o0[64 * j] = (unsigned long long)pk2(v0[j].x, v0[j].y) | ((unsigned long long)pk2(v0[j].z, v0[j].w) << 32);
            o1[64 * j] = (unsigned long long)pk2(v1[j].x, v1[j].y) | ((unsigned long long)pk2(v1[j].z, v1[j].w) << 32); }
    }
}

constexpr int RC_CB = 0, RC_CF = 17408, RC_HS = 51200, RC_EX = 68608;
template <bool PROMPT>
__device__ __forceinline__ void rec_unit(const Args& a, LAS unsigned char* lds, const int b, const int cg) {
    const int tid = threadIdx.x, lane = tid & 63, wave = __builtin_amdgcn_readfirstlane(tid >> 6), fr = lane & 15, fq = lane >> 4, cgw = wave & 3, th = wave >> 2;
    const bf16* zA = (const bf16*)(a.ws + WS_A);
    bf16* rec = (bf16*)((unsigned char*)a.out + OUT_REC);
    LAS bf16* Cb = (LAS bf16*)(lds + RC_CB); LAS float* Hs = (LAS float*)(lds + RC_HS); LAS float* EX = (LAS float*)(lds + RC_EX);
    {
        constexpr int T = PROMPT ? SEQ : SSEQ;
        const int row0 = PROMPT ? b * SEQ : MP + b * SSEQ;
        const float* conv_prev = PROMPT ? nullptr : a.in[I_SCONV] + (size_t)b * 3 * DM;
        const float* h0 = PROMPT ? nullptr : a.in[I_SLRU] + (size_t)b * DM;
        float* o_conv = a.out + (PROMPT ? O_CP : O_CS) + (size_t)b * 3 * DM;
        float* o_lru = a.out + (PROMPT ? O_LP : O_LS) + (size_t)b * DM;
        const int n = cg >> 1;
        const int chl = cgw * 16 + fr, c = cg * 64 + chl, e = (cg & 1) * 64 + chl;
        bf16x8 Br[4], Bi[4];
        { const bf16* wr_ = (const bf16*)(a.ws + WS_WRG) + (size_t)n * 16384 + e * 128 + 8 * fq; const bf16* wi_ = (const bf16*)(a.ws + WS_WIG) + (size_t)n * 16384 + e * 128 + 8 * fq;
#pragma unroll
          for (int ks = 0; ks < 4; ++ks) { Br[ks] = *(const bf16x8*)(wr_ + 32 * ks); Bi[ks] = *(const bf16x8*)(wi_ + 32 * ks); } }
        const float bias_r = a.in[I_BRG][c], bias_i = a.in[I_BIG][c];
        const float lam = a.in[I_LAM][c];
        const float sp = (lam < 0.f) ? (-lam + log1pf(expf(lam))) : log1pf(expf(-lam));
        const float sp8l = -8.f * sp * 1.4426950408889634f;
        float h = h0 ? h0[c] : 0.f;
        const int cp2 = 2 * lane, cch = n * 128 + cp2, tg8 = 8 * wave;
        typedef float f32x2 __attribute__((ext_vector_type(2)));
        f32x2 cw2[4];
#pragma unroll
        for (int j = 0; j < 4; ++j) cw2[j] = *(const f32x2*)(a.in[I_CONVW] + j * DM + cch);
        const f32x2 cb2 = *(const f32x2*)(a.in[I_CONVB] + cch);
        const int nchunks = (T + 63) / 64;
        unsigned xq[11];
#define REC_LOADX(CK) do { const int tb_ = (CK) * 64 + tg8 - 3; \
            _Pragma("unroll") for (int rr = 0; rr < 11; ++rr) { int trc_ = tb_ + rr; trc_ = trc_ < 0 ? 0 : trc_; trc_ = trc_ > T - 1 ? T - 1 : trc_; \
                xq[rr] = *(const unsigned*)(zA + (size_t)(row0 + trc_) * ZA_W + cch); } \
            if (conv_prev && (CK) == 0 && wave == 0) { _Pragma("unroll") for (int rr = 0; rr < 3; ++rr) { const f32x2 pv_ = *(const f32x2*)(conv_prev + (size_t)rr * DM + cch); xq[rr] = pk2(pv_.x, pv_.y); } } } while (0)
        REC_LOADX(0);
        for (int ck = 0; ck < nchunks; ++ck) {
            const int t0 = ck * 64, nt = (T - t0) < 64 ? (T - t0) : 64;
            {
                f32x2 xv[11];
#pragma unroll
                for (int rr = 0; rr < 11; ++rr) { unsigned w = xq[rr]; if (t0 + tg8 - 3 + rr < 0 && !conv_prev) w = 0u; xv[rr] = (f32x2){bflo(w), bfhi(w)}; }
#pragma unroll
                for (int i = 0; i < 8; ++i) {
                    f32x2 cv = cb2;
#pragma unroll
                    for (int j = 0; j < 4; ++j) cv += xv[i + j] * cw2[j];
                    if (tg8 + i >= nt) cv = (f32x2){0.f, 0.f};
                    *(LAS unsigned*)(Cb + (tg8 + i) * 136 + cp2) = pk2(cv.x, cv.y);
                }
            }
            if (ck + 1 < nchunks) REC_LOADX(ck + 1);
            const u32x4 gq = *(const u32x4*)(zA + (size_t)(row0 + (((tid >> 3) < nt) ? t0 + (tid >> 3) : t0)) * ZA_W + 1024 + cg * 64 + (tid & 7) * 8);
            __syncthreads();
            float av[2][4], bv[2][4], segA[2], segH[2];
#pragma unroll
            for (int mtl = 0; mtl < 2; ++mtl) {
                const int mt = 2 * th + mtl;
                f32x4 dr = (f32x4){0.f, 0.f, 0.f, 0.f}, di = (f32x4){0.f, 0.f, 0.f, 0.f};
                if (16 * mt < nt) {
#pragma unroll
                    for (int ks = 0; ks < 4; ++ks) { const bf16x8 af = *(const LAS bf16x8*)(Cb + (16 * mt + fr) * 136 + 32 * ks + 8 * fq);
                        dr = __builtin_amdgcn_mfma_f32_16x16x32_bf16(af, Br[ks], dr, 0, 0, 0); di = __builtin_amdgcn_mfma_f32_16x16x32_bf16(af, Bi[ks], di, 0, 0, 0); }
                }
                float A = 1.f, H = 0.f;
#pragma unroll
                for (int jj = 0; jj < 4; ++jj) {
                    const int tk = 16 * mt + 4 * fq + jj; float aa = 1.f, bb = 0.f;
                    if (tk < nt) {
                        const float er = __builtin_amdgcn_exp2f(fminf((dr[jj] + bias_r) * -1.4426950408889634f, 60.f)), ei = __builtin_amdgcn_exp2f(fminf((di[jj] + bias_i) * -1.4426950408889634f, 60.f));
                        const float pr_ = 1.f + er, pi_ = 1.f + ei, rc = __builtin_amdgcn_rcpf(pr_ * pi_);
                        const float r = pi_ * rc, ig = pr_ * rc;
                        const float la2 = r * sp8l;
                        aa = __builtin_amdgcn_exp2f(la2);
                        const float y = la2 * 1.3862943611198906f;
                        const float om = (y > -0.1f) ? (-y * (1.f + y * (0.5f + y * ((1.f / 6.f) + y * ((1.f / 24.f) + y * (1.f / 120.f)))))) : (1.f - aa * aa);
                        bb = __builtin_amdgcn_sqrtf(om) * ig * __uint_as_float((unsigned)Cb[tk * 136 + e] << 16);
                    }
                    av[mtl][jj] = aa; bv[mtl][jj] = bb; H = aa * H + bb; A *= aa;
                }
                segA[mtl] = A; segH[mtl] = H;
            }
            float PA[2], PH[2], TA[2], TH[2];
#pragma unroll
            for (int mtl = 0; mtl < 2; ++mtl) {
                float pa = 1.f, ph = 0.f, ta = 1.f, tht = 0.f;
#pragma unroll
                for (int q = 0; q < 4; ++q) { const float Aq = __shfl(segA[mtl], fr + 16 * q), Hq = __shfl(segH[mtl], fr + 16 * q);
                    if (q < fq) { ph = Aq * ph + Hq; pa *= Aq; } tht = Aq * tht + Hq; ta *= Aq; }
                PA[mtl] = pa; PH[mtl] = ph; TA[mtl] = ta; TH[mtl] = tht;
            }
            const float WA = TA[0] * TA[1], WH = TA[1] * TH[0] + TH[1];
            PH[1] = PA[1] * TH[0] + PH[1]; PA[1] = TA[0] * PA[1];
            if (fq == 0) { EX[((th * 4 + cgw) * 16 + fr) * 2 + 0] = WA; EX[((th * 4 + cgw) * 16 + fr) * 2 + 1] = WH; }
            __syncthreads();
            const float WA0 = EX[((0 * 4 + cgw) * 16 + fr) * 2 + 0], WH0 = EX[((0 * 4 + cgw) * 16 + fr) * 2 + 1], WA1 = EX[((1 * 4 + cgw) * 16 + fr) * 2 + 0], WH1 = EX[((1 * 4 + cgw) * 16 + fr) * 2 + 1];
            const float hmid = WA0 * h + WH0, hend = WA1 * hmid + WH1;
            const float hst = (th == 0) ? h : hmid;
#pragma unroll
            for (int mtl = 0; mtl < 2; ++mtl) {
                const int mt = 2 * th + mtl; float hc = PA[mtl] * hst + PH[mtl];
#pragma unroll
                for (int jj = 0; jj < 4; ++jj) { hc = av[mtl][jj] * hc + bv[mtl][jj]; Hs[(16 * mt + 4 * fq + jj) * 68 + chl] = hc; }
            }
            h = hend;
            __syncthreads();
            { const int tk = tid >> 3, c8 = (tid & 7) * 8;
              if (tk < nt) {
                const size_t row = (size_t)(row0 + t0 + tk);
                const u32x4 gw = gq;
                const f32x4 h0v = *(const LAS f32x4*)(Hs + tk * 68 + c8), h1v = *(const LAS f32x4*)(Hs + tk * 68 + c8 + 4);
                u32x4 w; w.x = pk2(gelu_tanh(bflo(gw.x)) * h0v.x, gelu_tanh(bfhi(gw.x)) * h0v.y); w.y = pk2(gelu_tanh(bflo(gw.y)) * h0v.z, gelu_tanh(bfhi(gw.y)) * h0v.w);
                w.z = pk2(gelu_tanh(bflo(gw.z)) * h1v.x, gelu_tanh(bfhi(gw.z)) * h1v.y); w.w = pk2(gelu_tanh(bflo(gw.w)) * h1v.z, gelu_tanh(bfhi(gw.w)) * h1v.w);
                *(u32x4*)(rec + row * DM + cg * 64 + c8) = w;
              } }
        }
#undef REC_LOADX
        if (th == 0 && fq == 0) o_lru[c] = h;
        if (tid < 192) { const int j = tid >> 6, ch = tid & 63; const unsigned w = zA[(size_t)(row0 + T - 3 + j) * ZA_W + cg * 64 + ch]; o_conv[j * DM + cg * 64 + ch] = __uint_as_float(w << 16); }
        __syncthreads();
    }
}
__device__ __forceinline__ void rec_phase(const Args& a, LAS unsigned char* lds, int G) {
    for (int u = blockIdx.x; u < 768; u += G) { if (u < 256) rec_unit<true>(a, lds, u >> 4, u & 15); else rec_unit<false>(a, lds, (u - 256) >> 4, (u - 256) & 15); }
}
constexpr int AT_KS = 0, AT_VT = 27648;
template <int NBLK, bool FULL = false>
__device__ __forceinline__ void attn_block(bf16* att, LAS bf16* Ks, LAS bf16* Vt, size_t qrow0, int hh, float sink, const bf16x8 (&q)[2][2], unsigned vst_, unsigned vval_, int fr, int fq) {
    const unsigned vst = FULL ? 0xFFFu : vst_, vval = FULL ? 0xFFFu : vval_;
    f32x4 st[NBLK][12];
#pragma unroll
    for (int kt = 0; kt < 12; ++kt) {
#pragma unroll
        for (int bi = 0; bi < NBLK; ++bi) st[bi][kt] = (f32x4){0.f, 0.f, 0.f, 0.f};
        if ((vst >> kt) & 1u) {
            const bf16x8 k0 = *(const LAS bf16x8*)(Ks + (16 * kt + fr) * 72 + 8 * fq), k1 = *(const LAS bf16x8*)(Ks + (16 * kt + fr) * 72 + 32 + 8 * fq);
#pragma unroll
            for (int bi = 0; bi < NBLK; ++bi) { st[bi][kt] = __builtin_amdgcn_mfma_f32_16x16x32_bf16(k0, q[bi][0], st[bi][kt], 0, 0, 0); st[bi][kt] = __builtin_amdgcn_mfma_f32_16x16x32_bf16(k1, q[bi][1], st[bi][kt], 0, 0, 0); }
        }
        if (FULL && (kt & 3) == 3) __builtin_amdgcn_sched_barrier(0);
    }
    float rl[NBLK];
#pragma unroll
    for (int bi = 0; bi < NBLK; ++bi) {
        constexpr float CS = 0.125f * 1.4426950408889634f;
        float mx = -1e30f;
#pragma unroll
        for (int kt = 0; kt < 12; ++kt) if ((vval >> kt) & 1u) mx = fmaxf(mx, fmaxf(fmaxf(st[bi][kt][0], st[bi][kt][1]), fmaxf(st[bi][kt][2], st[bi][kt][3])));
        mx = fmaxf(mx, __shfl_xor(mx, 16)); mx = fmaxf(mx, __shfl_xor(mx, 32));
        const float sink2 = sink * 1.4426950408889634f;
        const float m2 = fmaxf(mx * CS, sink2), nm2 = -m2;
        float l = 0.f;
#pragma unroll
        for (int kt = 0; kt < 12; ++kt) {
            if ((vval >> kt) & 1u) { st[bi][kt] = (f32x4){__builtin_amdgcn_exp2f(fmaf(st[bi][kt][0], CS, nm2)), __builtin_amdgcn_exp2f(fmaf(st[bi][kt][1], CS, nm2)), __builtin_amdgcn_exp2f(fmaf(st[bi][kt][2], CS, nm2)), __builtin_amdgcn_exp2f(fmaf(st[bi][kt][3], CS, nm2))}; l += (st[bi][kt][0] + st[bi][kt][1]) + (st[bi][kt][2] + st[bi][kt][3]); }
            else st[bi][kt] = (f32x4){0.f, 0.f, 0.f, 0.f};
        }
        l += __shfl_xor(l, 16); l += __shfl_xor(l, 32); l += __builtin_amdgcn_exp2f(sink2 - m2);
        rl[bi] = 1.f / l;
    }
    f32x4 o[NBLK][4];
#pragma unroll
    for (int bi = 0; bi < NBLK; ++bi)
#pragma unroll
        for (int dt = 0; dt < 4; ++dt) o[bi][dt] = (f32x4){0.f, 0.f, 0.f, 0.f};
#pragma unroll
    for (int kp = 0; kp < 6; ++kp) {
        if ((vst >> (2 * kp)) & 1u) {
            bf16x8 pf[NBLK];
#pragma unroll
            for (int bi = 0; bi < NBLK; ++bi) { u32x4 pw; pw.x = pk2(st[bi][2 * kp][0], st[bi][2 * kp][1]); pw.y = pk2(st[bi][2 * kp][2], st[bi][2 * kp][3]); pw.z = pk2(st[bi][2 * kp + 1][0], st[bi][2 * kp + 1][1]); pw.w = pk2(st[bi][2 * kp + 1][2], st[bi][2 * kp + 1][3]); pf[bi] = __builtin_bit_cast(bf16x8, pw); }
#pragma unroll
            for (int dt = 0; dt < 4; ++dt) {
                const u32x2 va = *(const LAS u32x2*)(Vt + (16 * dt + fr) * 200 + 32 * kp + 4 * fq), vb = *(const LAS u32x2*)(Vt + (16 * dt + fr) * 200 + 32 * kp + 16 + 4 * fq);
                const u32x4 vv = (u32x4){va.x, va.y, vb.x, vb.y};
#pragma unroll
                for (int bi = 0; bi < NBLK; ++bi) o[bi][dt] = __builtin_amdgcn_mfma_f32_16x16x32_bf16(__builtin_bit_cast(bf16x8, vv), pf[bi], o[bi][dt], 0, 0, 0);
            }
        }
        if (FULL) __builtin_amdgcn_sched_barrier(0);
    }
#pragma unroll
    for (int bi = 0; bi < NBLK; ++bi) {
        bf16* op = att + (qrow0 + 16 * bi) * DM + hh * 64 + 4 * fq;
#pragma unroll
        for (int dt = 0; dt < 4; ++dt) { u32x2 w; w.x = pk2(o[bi][dt][0] * rl[bi], o[bi][dt][1] * rl[bi]); w.y = pk2(o[bi][dt][2] * rl[bi], o[bi][dt][3] * rl[bi]); *(u32x2*)(op + 16 * dt) = w; }
    }
}
__device__ __forceinline__ void attn_store_piece(LAS bf16* Ks, LAS bf16* Vt, int r, int d8, u32x4 kw, u32x4 vw) {
    *(LAS u32x4*)(Ks + r * 72 + d8) = kw;
    Vt[(d8 + 0) * 200 + r] = (bf16)(vw.x & 0xffffu); Vt[(d8 + 1) * 200 + r] = (bf16)(vw.x >> 16);
    Vt[(d8 + 2) * 200 + r] = (bf16)(vw.y & 0xffffu); Vt[(d8 + 3) * 200 + r] = (bf16)(vw.y >> 16);
    Vt[(d8 + 4) * 200 + r] = (bf16)(vw.z & 0xffffu); Vt[(d8 + 5) * 200 + r] = (bf16)(vw.z >> 16);
    Vt[(d8 + 6) * 200 + r] = (bf16)(vw.w & 0xffffu); Vt[(d8 + 7) * 200 + r] = (bf16)(vw.w >> 16);
}
__device__ __forceinline__ void attn_phase(const Args& a, LAS unsigned char* lds, int G) {
    const int tid = threadIdx.x, lane = tid & 63, wave = __builtin_amdgcn_readfirstlane(tid >> 6), fr = lane & 15, fq = lane >> 4;
    const bf16* zA = (const bf16*)(a.ws + WS_A);
    bf16* att = (bf16*)(a.ws + WS_C);
    LAS bf16* Ks = (LAS bf16*)(lds + AT_KS); LAS bf16* Vt = (LAS bf16*)(lds + AT_VT);
    const float* sinks = a.in[I_SINK];
    for (int sg = blockIdx.x; sg < 256; sg += G) {
        const int bk = sg >> 2, b = bk >> 2, kvh = bk & 3, c0 = (sg & 3) * 16;
        const int r = tid >> 3, d8 = (tid & 7) * 8;
        const bf16* kbase = zA + ((size_t)b * SEQ + r) * ZA_W + 3072 + kvh * 64 + d8;
        for (int cc = c0 - 2; cc <= c0; ++cc) if (cc >= 0) {
            const u32x4 kw = *(const u32x4*)(kbase + (size_t)cc * 64 * ZA_W), vw = *(const u32x4*)(kbase + (size_t)cc * 64 * ZA_W + 256);
            attn_store_piece(Ks, Vt, (cc % 3) * 64 + r, d8, kw, vw);
        }
        __syncthreads();
        const int g = wave >> 1, hh = kvh * 4 + g; const float sink2 = sinks[hh] * 1.4426950408889634f;
        const bf16* qbase = zA + ((size_t)b * SEQ + (wave & 1) * 32 + fr) * ZA_W + 2048 + hh * 64 + 8 * fq;
        bf16x8 qf[2][2];
#pragma unroll
        for (int bi = 0; bi < 2; ++bi) { const bf16* qp = qbase + (size_t)(c0 * 64 + bi * 16) * ZA_W; qf[bi][0] = *(const bf16x8*)qp; qf[bi][1] = *(const bf16x8*)(qp + 32); }
        for (int c = c0; c < c0 + 16; ++c) {
            const bool more = (c + 1 < c0 + 16);
            u32x4 kw = (u32x4){0u, 0u, 0u, 0u}, vw = (u32x4){0u, 0u, 0u, 0u};
            bf16x8 qn[2][2];
#pragma unroll
            for (int bi = 0; bi < 2; ++bi) { qn[bi][0] = qf[bi][0]; qn[bi][1] = qf[bi][1]; }
            { const int cn = more ? c + 1 : c;
              kw = *(const u32x4*)(kbase + (size_t)cn * 64 * ZA_W); vw = *(const u32x4*)(kbase + (size_t)cn * 64 * ZA_W + 256);
#pragma unroll
              for (int bi = 0; bi < 2; ++bi) { const bf16* qp = qbase + (size_t)(cn * 64 + bi * 16) * ZA_W; qn[bi][0] = *(const bf16x8*)qp; qn[bi][1] = *(const bf16x8*)(qp + 32); } }
            unsigned vm = 0xFu << (4 * (c % 3));
            if (c >= 1) vm |= 0xFu << (4 * ((c - 1) % 3));
            if (c >= 2) vm |= 0xFu << (4 * ((c - 2) % 3));
            if (c >= 2) attn_block<2, true>(att, Ks, Vt, (size_t)b * SEQ + c * 64 + (wave & 1) * 32 + fr, hh, sink2 * 0.6931471805599453f, qf, 0xFFFu, 0xFFFu, fr, fq);
            else attn_block<2, false>(att, Ks, Vt, (size_t)b * SEQ + c * 64 + (wave & 1) * 32 + fr, hh, sink2 * 0.6931471805599453f, qf, vm, vm, fr, fq);
#pragma unroll
            for (int bi = 0; bi < 2; ++bi) { qf[bi][0] = qn[bi][0]; qf[bi][1] = qn[bi][1]; }
            __syncthreads();
            if (more) attn_store_piece(Ks, Vt, ((c + 1) % 3) * 64 + r, d8, kw, vw);
            __syncthreads();
        }
    }
    for (int us = blockIdx.x; us < 128; us += G) {
        const int b = us >> 2, kvh = us & 3;
#pragma unroll
        for (int i = 0; i < 3; ++i) {
            const int idx = tid + 512 * i, r = idx >> 3, d8 = (idx & 7) * 8;
            if (r < 160) {
                u32x4 kw, vw;
                if (r < CW) { const float* kp = a.in[I_CK] + ((size_t)(b * CW + r) * NKV + kvh) * HD + d8; const float* vp = a.in[I_CV] + ((size_t)(b * CW + r) * NKV + kvh) * HD + d8;
                    const f32x4 k0 = *(const f32x4*)kp, k1 = *(const f32x4*)(kp + 4), v0 = *(const f32x4*)vp, v1 = *(const f32x4*)(vp + 4);
                    kw.x = pk2(k0.x, k0.y); kw.y = pk2(k0.z, k0.w); kw.z = pk2(k1.x, k1.y); kw.w = pk2(k1.z, k1.w);
                    vw.x = pk2(v0.x, v0.y); vw.y = pk2(v0.z, v0.w); vw.z = pk2(v1.x, v1.y); vw.w = pk2(v1.z, v1.w); }
                else if (r < CW + SSEQ) { const size_t grow = (size_t)MP + (size_t)b * SSEQ + (r - CW);
                    kw = *(const u32x4*)(zA + grow * ZA_W + 3072 + kvh * 64 + d8); vw = *(const u32x4*)(zA + grow * ZA_W + 3328 + kvh * 64 + d8); }
                else { kw = (u32x4){0u, 0u, 0u, 0u}; vw = (u32x4){0u, 0u, 0u, 0u}; }
                attn_store_piece(Ks, Vt, r, d8, kw, vw);
            }
        }
        __syncthreads();
        if (wave < 4) { const int hh = kvh * 4 + wave; const size_t qrow = (size_t)MP + b * SSEQ + fr; const bf16* qp = zA + qrow * ZA_W + 2048 + hh * 64 + 8 * fq;
            bf16x8 qs[2][2]; qs[0][0] = *(const bf16x8*)qp; qs[0][1] = *(const bf16x8*)(qp + 32); qs[1][0] = qs[0][0]; qs[1][1] = qs[0][1];
            attn_block<1>(att, Ks, Vt, qrow, hh, sinks[hh], qs, 0x3FFu, 0x1FFu, fr, fq); }
        __syncthreads();
    }
}
__device__ __forceinline__ void kv_out_phase(const Args& a, int G) {
    const bf16* zA = (const bf16*)(a.ws + WS_A);
    const int gt = blockIdx.x * NTHREADS + threadIdx.x, NGT = G * NTHREADS;
    constexpr int NP = NB * CW * 64, NS = MS * 64;
    for (int i = gt; i < NP + NS; i += NGT) {
        int row_src; float* dst; int col;
        if (i < NP) { const int r = i >> 6; col = (i & 63) * 8; const int b = r >> 7, w = r & 127; row_src = b * SEQ + SEQ - CW + w; dst = a.out + ((col < 256) ? O_KP : O_VP) + (size_t)r * 256 + (col & 255); }
        else { const int j = i - NP; const int r = j >> 6; col = (j & 63) * 8; row_src = MP + r; dst = a.out + ((col < 256) ? O_KS : O_VS) + (size_t)r * 256 + (col & 255); }
        const u32x4 w = *(const u32x4*)(zA + (size_t)row_src * ZA_W + 3072 + col);
        *(f32x4*)dst = (f32x4){bflo(w.x), bfhi(w.x), bflo(w.y), bfhi(w.y)}; *(f32x4*)(dst + 4) = (f32x4){bflo(w.z), bfhi(w.z), bflo(w.w), bfhi(w.w)};
    }
}
__device__ __forceinline__ void final_phase(const Args& a, int G) {
    const int tid = threadIdx.x, lane = tid & 63, wave = tid >> 6;
    const int gw = blockIdx.x * NWAVES + wave, NGW = G * NWAVES;
    const float* ss = (const float*)(a.ws + WS_SS3);
    const bf16* h3 = (const bf16*)(a.ws + WS_B);
    const f32x4* g4 = (const f32x4*)a.in[I_NFIN];
    const f32x4 ga0 = g4[2 * lane], ga1 = g4[2 * lane + 1], gb0 = g4[128 + 2 * lane], gb1 = g4[128 + 2 * lane + 1];
    for (int mb = gw; mb < MT; mb += 4 * NGW) {
        int mr[4]; u32x4 wa[4], wb[4]; float rs[4];
#pragma unroll
        for (int k = 0; k < 4; ++k) { mr[k] = (mb + k * NGW < MT) ? mb + k * NGW : mb; wa[k] = *(const u32x4*)(h3 + (size_t)mr[k] * DM + 8 * lane); wb[k] = *(const u32x4*)(h3 + (size_t)mr[k] * DM + 512 + 8 * lane); }
#pragma unroll
        for (int k = 0; k < 4; ++k) rs[k] = rowscale(ss, mr[k]);
#pragma unroll
        for (int k = 0; k < 4; ++k) {
            f32x4 a0, a1, b0, b1; UNPK8(wa[k], a0, a1); UNPK8(wb[k], b0, b1);
            f32x4* yr = (f32x4*)(a.out + (size_t)mr[k] * DM);
            __builtin_nontemporal_store(a0 * rs[k] * ga0, &yr[2 * lane]); __builtin_nontemporal_store(a1 * rs[k] * ga1, &yr[2 * lane + 1]);
            __builtin_nontemporal_store(b0 * rs[k] * gb0, &yr[128 + 2 * lane]); __builtin_nontemporal_store(b1 * rs[k] * gb1, &yr[128 + 2 * lane + 1]);
        }
    }
}

#define XB_TMO      128
#define XB_XCNT(j)  (256  + 64 * (j))
#define XB_XSUB(j)  (1280 + 64 * (j))
#define XB_XGEN(j)  (2304 + 64 * (j))
#define XB_TOP      3328
#define XB_TOPGEN   3392
#define XCD_BAR_WORDS 3456
#define XB_SPIN_CAP (1u << 18)

__device__ __forceinline__ unsigned xb_ld(unsigned* p)              { return __hip_atomic_load(p, __ATOMIC_RELAXED, __HIP_MEMORY_SCOPE_AGENT); }
__device__ __forceinline__ unsigned xb_add(unsigned* p, unsigned v) { return __hip_atomic_fetch_add(p, v, __ATOMIC_RELAXED, __HIP_MEMORY_SCOPE_AGENT); }
__device__ __forceinline__ unsigned xb_xcc_id() { return (unsigned)__builtin_amdgcn_s_getreg((3 << 11) | 20) & 0xFu; }
#define XB_SPIN(cond, bar) do { unsigned _sp = 0; while (cond) { __builtin_amdgcn_s_sleep(1); \
    if ((++_sp & 255u) == 0u) { if (xb_ld(&(bar)[XB_TMO])) break; if (_sp > XB_SPIN_CAP) { atomicAdd(&(bar)[XB_TMO], 1u); break; } } } } while (0)

struct XcdBarrier {
    unsigned* bar; unsigned x;
    volatile LAS unsigned* st;
};

__device__ __forceinline__ XcdBarrier xcd_barrier_post(unsigned* bar, volatile LAS unsigned* st) {
    XcdBarrier b; b.bar = bar; b.x = xb_xcc_id(); b.st = st;
    if (threadIdx.x == 0) (void)xb_add(&bar[XB_XCNT(b.x)], 1u);
    return b;
}
__device__ __forceinline__ void xcd_barrier_complete(unsigned* bar, unsigned x, unsigned& nloc, unsigned& nx) {
    const unsigned G = gridDim.x * gridDim.y * gridDim.z;
    unsigned sum, cnt, mine, sp = 0u;
    for (;;) {
        sum = 0u; cnt = 0u; mine = 0u;
#pragma unroll
        for (unsigned j = 0; j < 16; ++j) { const unsigned c = xb_ld(&bar[XB_XCNT(j)]); sum += c; cnt += (c > 0u) ? 1u : 0u; mine = (j == x) ? c : mine; }
        if (sum == G) break;
        __builtin_amdgcn_s_sleep(1);
        if ((++sp & 255u) == 0u) { if (xb_ld(&bar[XB_TMO])) break; if (sp > XB_SPIN_CAP) { atomicAdd(&bar[XB_TMO], 1u); break; } }
    }
    nloc = mine > 0u ? mine : 1u; nx = cnt > 0u ? cnt : 1u;
}

__device__ __forceinline__ void xcd_barrier(const XcdBarrier& b) {
    asm volatile("s_waitcnt vmcnt(0)" ::: "memory");
    __syncthreads();
    if (threadIdx.x == 0) {
        unsigned* bar = b.bar;
        __builtin_amdgcn_s_waitcnt(0);
        unsigned nloc = b.st[0], nx = b.st[1];
        if (nloc == 0u) { xcd_barrier_complete(bar, b.x, nloc, nx); b.st[0] = nloc; b.st[1] = nx; }
        const unsigned old = xb_add(&bar[XB_XSUB(b.x)], 1u);
        const unsigned gen = old / nloc;
        if (old + 1u == (gen + 1u) * nloc) {
            __builtin_amdgcn_fence(__ATOMIC_RELEASE, "agent");
            asm volatile("s_waitcnt vmcnt(0)" ::: "memory");
            const unsigned og = xb_add(&bar[XB_TOP], 1u);
            const unsigned tg = og / nx;
            if (og + 1u == (tg + 1u) * nx) xb_add(&bar[XB_TOPGEN], 1u);
            else XB_SPIN(xb_ld(&bar[XB_TOPGEN]) == tg, bar);
            __builtin_amdgcn_fence(__ATOMIC_ACQUIRE, "agent");
            xb_add(&bar[XB_XGEN(b.x)], 1u);
            asm volatile("s_waitcnt vmcnt(0)" ::: "memory");
        } else {
            XB_SPIN(xb_ld(&bar[XB_XGEN(b.x)]) == gen, bar);
            __builtin_amdgcn_fence(__ATOMIC_ACQUIRE, "agent");
            asm volatile("s_waitcnt vmcnt(0)" ::: "memory");
        }
    }
    __syncthreads();
}

__global__ void __launch_bounds__(NTHREADS, 2) mk_fwd(Args a) {
    extern __shared__ __attribute__((aligned(16))) unsigned char lds_raw[];
    LAS unsigned char* lds = (LAS unsigned char*)lds_raw;
    const int G = gridDim.x, lo = a.ph_lo, hi = a.ph_hi;
    const int wid_k = __builtin_amdgcn_readfirstlane((int)(threadIdx.x >> 6));
    unsigned char* ws = a.ws;
#define IN(k) (lo <= (k) && (k) < hi)
#ifndef PROBE_DUP
#define PROBE_DUP 0
#endif
#define REP(k) for (int rep_ = 0; rep_ < (((PROBE_DUP) >> (k)) & 1) + 1; ++rep_)
    volatile LAS unsigned* barst = (volatile LAS unsigned*)(lds + LDS_BARST);
    if (threadIdx.x < 2) barst[threadIdx.x] = 0u;
    __syncthreads();
    XcdBarrier xbar; xbar.bar = (unsigned*)(ws + WS_CTL); xbar.x = 0; xbar.st = barst;
    if (a.coop) xbar = xcd_barrier_post((unsigned*)(ws + WS_CTL), barst);
    unsigned* vcnt = (unsigned*)(ws + WS_CTL) + 8192;
    const unsigned myxcc = xb_xcc_id();
    if (a.coop && threadIdx.x == 0) barst[2] = xb_add(&vcnt[64 * myxcc], 1u);
    __syncthreads();
    const int vrank = (int)barst[2];
    int vc = (int)blockIdx.x;
#define SEAM(k) do { if (a.coop && IN(k) && IN((k) + 1)) { if (a.coop == 2) cg::this_grid().sync(); else xcd_barrier(xbar); } } while (0)
    typedef pg8::StaticOrder SO;
    bf16* h1 = (bf16*)((unsigned char*)a.out + OUT_H1);
    bf16* recb = (bf16*)((unsigned char*)a.out + OUT_REC);

    if (IN(0)) p0_prologue(a, lds, G);
    SEAM(0);
    if (a.coop && (G & 7) == 0) {
        bool ok = true;
#pragma unroll
        for (int j = 0; j < 16; ++j) { const unsigned cj = xb_ld(&vcnt[64 * j]); ok = ok && (cj == (j < 8 ? (unsigned)(G >> 3) : 0u)); }
        if (ok) vc = vrank * 8 + (int)myxcc;
    }
    vc = __builtin_amdgcn_readfirstlane(vc);
    if (IN(1)) {
        pg8::Gemm g{(const bf16*)(ws + WS_B), (const bf16*)(ws + WS_WGU1), MT, DIN, DM, DM}; SO S; S.init(MT, DIN, G, vc);
        EpiSwiGLU<true> E{(bf16*)(ws + WS_A), (const float*)(ws + WS_SS0)};
        pg8::gemm_phase<EpiSwiGLU<true>, SO, true, true>(lds, g, S, E);
    }
    SEAM(1);
    if (IN(2)) {
        pg8::Gemm g{(const bf16*)(ws + WS_A), (const bf16*)(ws + WS_WD1), MP, DM, DFF, DFF};
        typedef ComboOrder<DM / 256, DFF / 256, 256> CO; typedef EpiResSplit<DM / 256, 256> ERS;
        CO S; S.so.init(MP, DM, G, vc); S.sp.G = G; S.sp.c = vc; S.rounds = (vc < (MP / 256) * (DM / 256)) ? ((MP / 256) * (DM / 256) - vc + G - 1) / G : 0;
        ERS E{{(const bf16*)(ws + WS_B), nullptr, h1, (float*)(ws + WS_SS1), 0.5f}, {(f32x4*)(ws + WS_PART)}};
        pg8::gemm_phase<ERS, CO, true, true>(lds, g, S, E);
        if (a.coop) xcd_barrier(xbar);
        splitk_fixup_res<DFF / 256>((const bf16*)E.R.res, (bf16*)E.R.out, E.R.ss, 0.5f, (const f32x4*)(ws + WS_PART), DM / 256, G, wid_k);
    }
    SEAM(2);
    if (IN(3)) {
        pg8::Gemm g{h1, (const bf16*)(ws + WS_WIN), MT, DIN, DM, DM}; SO S; S.init(MT, DIN, G, vc);
        EpiWin E{(bf16*)(ws + WS_A), (bf16*)(ws + WS_B), (const float*)(ws + WS_SS1)};
        pg8::gemm_phase<EpiWin, SO, true, true>(lds, g, S, E);
    }
    SEAM(3);
    if (IN(4)) { REP(10) rec_phase(a, lds, G); REP(11) attn_phase(a, lds, G); kv_out_phase(a, G); }
    SEAM(4);
    if (IN(5)) {
        { pg8::Gemm g{recb, (const bf16*)(ws + WS_WBR), MT, DM, DM, DM}; SO S; S.init(MT, DM, G, vc);
          EpiBranch<false> E{(bf16*)(ws + WS_A), (const bf16*)(ws + WS_B), 0};
          pg8::gemm_phase<EpiBranch<false>, SO, true, true>(lds, g, S, E); }
        { pg8::Gemm g{(const bf16*)(ws + WS_C), (const bf16*)(ws + WS_WBA), MT, DM, DM, DM}; SO S; S.init(MT, DM, G, vc);
          EpiBranch<true> E{(bf16*)(ws + WS_A), (const bf16*)(ws + WS_B), 1024};
          pg8::gemm_phase<EpiBranch<true>, SO, true, true>(lds, g, S, E); }
    }
    SEAM(5);
    if (IN(6)) {
        pg8::Gemm g{(const bf16*)(ws + WS_A), (const bf16*)(ws + WS_WOUT), MT, DM, DM, DM}; SO S; S.init(MT, DM, G, vc);
        EpiRes<true, false> E{h1, nullptr, (bf16*)(ws + WS_B), (float*)(ws + WS_SS2), 1.0f};
        pg8::gemm_phase<EpiRes<true, false>, SO, true, true>(lds, g, S, E);
    }
    SEAM(6);
    if (IN(7)) {
        pg8::Gemm g{(const bf16*)(ws + WS_B), (const bf16*)(ws + WS_WGU2), MT, DIN, DM, DM}; SO S; S.init(MT, DIN, G, vc);
        EpiSwiGLU<true> E{(bf16*)(ws + WS_A), (const float*)(ws + WS_SS2)};
        pg8::gemm_phase<EpiSwiGLU<true>, SO, true, true>(lds, g, S, E);
    }
    SEAM(7);
    if (IN(8)) {
        pg8::Gemm g{(const bf16*)(ws + WS_A), (const bf16*)(ws + WS_WD2), MP, DM, DFF, DFF};
        typedef ComboOrder<DM / 256, DFF / 256, 256> CO; typedef EpiResSplit<DM / 256, 256> ERS;
        CO S; S.so.init(MP, DM, G, vc); S.sp.G = G; S.sp.c = vc; S.rounds = (vc < (MP / 256) * (DM / 256)) ? ((MP / 256) * (DM / 256) - vc + G - 1) / G : 0;
        ERS E{{(const bf16*)(ws + WS_B), nullptr, (bf16*)(ws + WS_B), (float*)(ws + WS_SS3), 0.5f}, {(f32x4*)(ws + WS_PART)}};
        pg8::gemm_phase<ERS, CO, true, true>(lds, g, S, E);
        if (a.coop) xcd_barrier(xbar);
        splitk_fixup_res<DFF / 256>((const bf16*)E.R.res, (bf16*)E.R.out, E.R.ss, 0.5f, (const f32x4*)(ws + WS_PART), DM / 256, G, wid_k);
    }
    SEAM(8);
    if (IN(9)) final_phase(a, G);
#undef IN
#undef SEAM
}

#ifndef MK_ONE_LAUNCH
#define MK_ONE_LAUNCH 1
#endif
extern "C" void kernel_launch(void* const* d_in, const int* in_sizes, int n_in, void* d_out, int out_size, void* d_ws, size_t ws_size, hipStream_t stream) {
    static int grid = 0;
    if (grid == 0) {
        if (n_in != 27 || in_sizes[0] != MP * DM || (size_t)out_size != O_END || ws_size < WS_END) {
            fprintf(stderr, "kernel_launch: unexpected shapes: n_in %d in0 %d out %d ws %zu (need %zu)\n", n_in, n_in > 0 ? in_sizes[0] : -1, out_size, ws_size, (size_t)WS_END); grid = -1; return; }
        int dev = 0, cus = 0, per_cu = 0;
        if (hipGetDevice(&dev) != hipSuccess || hipDeviceGetAttribute(&cus, hipDeviceAttributeMultiprocessorCount, dev) != hipSuccess) { grid = -1; return; }
        if (hipFuncSetAttribute((const void*)mk_fwd, hipFuncAttributeMaxDynamicSharedMemorySize, LDS_BYTES) != hipSuccess) { fprintf(stderr, "kernel_launch: hipFuncSetAttribute failed\n"); grid = -1; return; }
        if (hipOccupancyMaxActiveBlocksPerMultiprocessor(&per_cu, (const void*)mk_fwd, NTHREADS, LDS_BYTES) != hipSuccess || per_cu < 1) { fprintf(stderr, "kernel_launch: occupancy query gave %d\n", per_cu); per_cu = 1; }
        (void)hipGetLastError();
        grid = cus * per_cu;
        fprintf(stderr, "kernel_launch: grid %d (cus %d x %d)\n", grid, cus, per_cu);
    }
    if (grid < 0) return;
    Args a{};
    for (int i = 0; i < 27; ++i) a.in[i] = (const float*)d_in[i];
    a.out = (float*)d_out; a.ws = (unsigned char*)d_ws;
#if MK_ONE_LAUNCH
    if (hipMemsetAsync((char*)d_ws + WS_CTL, 0, CTL_ZERO_BYTES, stream) != hipSuccess) { fprintf(stderr, "kernel_launch: hipMemsetAsync failed\n"); return; }
    a.ph_lo = 0; a.ph_hi = N_PHASES; a.coop = 1;
    void* args[] = {&a};
    hipError_t e = hipLaunchCooperativeKernel((const void*)mk_fwd, dim3(grid), dim3(NTHREADS), args, LDS_BYTES, stream);
    if (e != hipSuccess) fprintf(stderr, "kernel_launch: cooperative launch failed: %s (grid %d)\n", hipGetErrorString(e), grid);
#else
    for (int p = 0; p < N_PHASES; ++p) {
        a.ph_lo = p; a.ph_hi = p + 1; a.coop = 0;
        hipLaunchKernelGGL(mk_fwd, dim3(grid), dim3(NTHREADS), LDS_BYTES, stream, a);
    }
#endif
}
```

```cpp
#include <hip/hip_runtime.h>
#include <hip/hip_cooperative_groups.h>
#include <cstdio>
#include <cstdint>
namespace cg = cooperative_groups;
namespace pg8 {
#define PG8_LAS __attribute__((address_space(3)))
typedef unsigned short bf16_t;
typedef short bf16x8 __attribute__((ext_vector_type(8)));
typedef float f32x4 __attribute__((ext_vector_type(4)));
typedef unsigned u32x4 __attribute__((ext_vector_type(4)));
constexpr int BM = 256, BK = 64, HALF = 128, HTB = HALF * BK * 2  , STAGE_BYTES = 8 * HTB, NXCD = 8, WGM = 8;

__host__ __device__ __forceinline__ int lds_byte(int r, int c) { const int st = (r >> 4) * 2 + (c >> 5), rr = r & 15, cc = c & 31, ob = rr * 64 + cc * 2; return st * 1024 + (ob ^ (((ob >> 9) & 1) << 5)); }
__host__ __device__ __forceinline__ void stage_rc(int b, int& R, int& C) { const int st = b / 1024, sb = b % 1024, swz = sb ^ (((sb >> 9) & 1) << 5); R = (st >> 1) * 16 + swz / 64; C = (st & 1) * 32 + (swz % 64) / 2; }
__host__ __device__ __forceinline__ int perm32(int rho) { const int n = rho >> 4, i = rho & 15; return 8 * (i >> 2) + 4 * n + (i & 3); }

struct Unit { int pm, pn, ko, nt; };
struct Gemm { const bf16_t* A; const bf16_t* Bt; int M, N, K, ld; };

struct StaticOrder {
    int nM, nN, nwg, G, c;
    __host__ __device__ void init(int M, int N, int G_, int c_) { nM = M / BM; nN = N / BM; nwg = nM * nN; G = G_; c = c_; }
    __host__ __device__ bool next(int i, Unit& u) const {
        const long L = (long)i * G + c; if (L >= nwg) return false;
        int wgid = (int)L; { const int q = nwg / NXCD, r = nwg % NXCD, xcd = wgid % NXCD, off = wgid / NXCD; wgid = (xcd < r ? xcd * (q + 1) : r * (q + 1) + (xcd - r) * q) + off; }
        const int nig = WGM * nN, gid = wgid / nig, fm = gid * WGM, gsz = (nM - fm) < WGM ? (nM - fm) : WGM;
        u.pm = fm + ((wgid % nig) % gsz); u.pn = (wgid % nig) / gsz; u.ko = 0; u.nt = 0; return true;
    }
    __device__ __forceinline__ void a_ready(const Unit&) const {}
    __device__ __forceinline__ void done(const Unit&) const {}
};
__device__ __forceinline__ unsigned cvt_pk_bf16(float lo, float hi) { unsigned r; asm volatile("v_cvt_pk_bf16_f32 %0, %1, %2" : "=v"(r) : "v"(lo), "v"(hi)); return r; }
typedef float f32x2 __attribute__((ext_vector_type(2)));
template <class Epi, class Sched, bool ALIGN_EPI = false, bool SP2 = false>
__device__ __forceinline__ void gemm_phase(PG8_LAS unsigned char* lds, const Gemm g, const Sched& S, const Epi& E) {
    const int tid = threadIdx.x, wid = __builtin_amdgcn_readfirstlane(tid >> 6), lane = tid & 63, wr = wid >> 2, wc = wid & 3, fr = lane & 15, fq = lane >> 4;
    const int K = g.ld, nt0 = g.K / BK;
    unsigned voffA[2], voffB[2];
#pragma unroll
    for (int i = 0; i < 2; ++i) { int R, C; stage_rc(tid * 16 + i * 8192, R, C); const int Rb = Epi::PERM ? ((R & ~31) + perm32(R & 31)) : R;
        voffA[i] = (unsigned)(R * K + C) * 2u; voffB[i] = (unsigned)(Rb * K + C) * 2u; }
    const size_t kstep = (size_t)(BK * 2);
    const size_t hstep = (size_t)HALF * K * 2;
    const size_t tstep = 2 * hstep;
    const unsigned ldsw = (unsigned)wid * 1024u;
    const int aoff = lds_byte(wr * 64 + fr, fq * 8), boff = lds_byte(wc * 32 + fr, fq * 8);
#define PG8_SA(b, h) (((b) * 2 + (h)) * HTB)
#define PG8_SB(b, h) ((4 + (b) * 2 + (h)) * HTB)
#define PG8_STAGE(bufoff, gbase, voff) do { _Pragma("unroll") for (int _i = 0; _i < 2; ++_i) \
        __builtin_amdgcn_global_load_lds((const unsigned*)((const char*)(gbase) + (voff)[_i]), (PG8_LAS unsigned*)(lds + (bufoff) + ldsw + _i * 8192), 16, 0, 0); } while (0)
#define PG8_LDA(dst, b, h) do { _Pragma("unroll") for (int m = 0; m < 4; ++m) _Pragma("unroll") for (int k = 0; k < 2; ++k) dst[m][k] = *(const PG8_LAS bf16x8*)(lds + PG8_SA(b, h) + aoff + m * 2048 + k * 1024); } while (0)
#define PG8_LDB(dst, b, h) do { _Pragma("unroll") for (int n = 0; n < 2; ++n) _Pragma("unroll") for (int k = 0; k < 2; ++k) dst[n][k] = *(const PG8_LAS bf16x8*)(lds + PG8_SB(b, h) + boff + n * 2048 + k * 1024); } while (0)
#define PG8_MMA(ai, bj, At, Bt) do { __builtin_amdgcn_s_setprio(1); _Pragma("unroll") for (int m = 0; m < 4; ++m) _Pragma("unroll") for (int n = 0; n < 2; ++n) _Pragma("unroll") for (int k = 0; k < 2; ++k) \
        acc[ai][bj][m][n] = __builtin_amdgcn_mfma_f32_16x16x32_bf16(Bt[n][k], At[m][k], acc[ai][bj][m][n], 0, 0, 0); __builtin_amdgcn_s_setprio(0); } while (0)
#define PG8_WAIT_V(n) asm volatile("s_waitcnt vmcnt(" #n ")" ::: "memory")
#define PG8_WAIT_L(n) asm volatile("s_waitcnt lgkmcnt(" #n ")" ::: "memory")
#define PG8_BAR __builtin_amdgcn_s_barrier()
#define PG8_SCHED __builtin_amdgcn_sched_barrier(0)
    Unit cur, nxt; int ui = 0;
    if (!S.next(0, cur)) return;
    f32x4 acc[2][2][4][2];
#pragma unroll
    for (int a = 0; a < 2; ++a)
#pragma unroll
        for (int b = 0; b < 2; ++b)
#pragma unroll
            for (int m = 0; m < 4; ++m)
#pragma unroll
                for (int n = 0; n < 2; ++n) acc[a][b][m][n] = (f32x4){0.f, 0.f, 0.f, 0.f};
    bf16x8 At[4][2], B0[2][2], B1[2][2];
    const char* cA = (const char*)g.A + (size_t)cur.pm * tstep + (size_t)cur.ko * 2; const char* cB = (const char*)g.Bt + (size_t)cur.pn * tstep + (size_t)cur.ko * 2;
    S.a_ready(cur);
    if constexpr (SP2) {
        PG8_STAGE(PG8_SB(0, 0), cB, voffB); PG8_STAGE(PG8_SB(0, 1), cB + hstep, voffB); PG8_STAGE(PG8_SA(0, 0), cA, voffA); PG8_STAGE(PG8_SA(0, 1), cA + hstep, voffA);
        if (wr == 1) PG8_BAR;
        PG8_WAIT_V(2); PG8_BAR;
        PG8_STAGE(PG8_SB(1, 0), cB + kstep, voffB); PG8_STAGE(PG8_SA(1, 0), cA + kstep, voffA); PG8_STAGE(PG8_SB(1, 1), cB + hstep + kstep, voffB);
        PG8_WAIT_V(6); PG8_BAR;
    } else {
        PG8_STAGE(PG8_SB(0, 0), cB, voffB); PG8_STAGE(PG8_SA(0, 0), cA, voffA); PG8_STAGE(PG8_SB(0, 1), cB + hstep, voffB); PG8_STAGE(PG8_SA(0, 1), cA + hstep, voffA);
        if (wr == 1) PG8_BAR;
        PG8_WAIT_V(4); PG8_BAR;
        PG8_STAGE(PG8_SB(1, 0), cB + kstep, voffB); PG8_STAGE(PG8_SA(1, 0), cA + kstep, voffA); PG8_STAGE(PG8_SB(1, 1), cB + hstep + kstep, voffB);
        PG8_WAIT_V(6); PG8_BAR;
    }
    for (;;) {
        const bool has_next = S.next(ui + 1, nxt);
        const int nt = cur.nt ? cur.nt : nt0;
        const char* nA = has_next ? (const char*)g.A + (size_t)nxt.pm * tstep + (size_t)nxt.ko * 2 : cA; const char* nB = has_next ? (const char*)g.Bt + (size_t)nxt.pn * tstep + (size_t)nxt.ko * 2 : cB;
        for (int t = 0; t < nt; t += 2) {
            const bool last = (t == nt - 2);
            const char* a1 = cA + (size_t)(t + 1) * kstep;
            const char* a2 = last ? nA : cA + (size_t)(t + 2) * kstep; const char* b2 = last ? nB : cB + (size_t)(t + 2) * kstep;
            const char* a3 = a2 + kstep; const char* b3 = b2 + kstep;
            if (last && has_next) S.a_ready(nxt);
            if constexpr (SP2) {
            PG8_LDB(B0, 0, 0); PG8_LDB(B1, 0, 1); PG8_SCHED; PG8_LDA(At, 0, 0); PG8_STAGE(PG8_SA(1, 1), a1 + hstep, voffA);
            PG8_WAIT_V(8); PG8_WAIT_L(0); PG8_BAR; PG8_MMA(0, 0, At, B0); PG8_MMA(0, 1, At, B1); PG8_BAR; PG8_SCHED;
            PG8_LDA(At, 0, 1); PG8_STAGE(PG8_SB(0, 0), b2, voffB); PG8_STAGE(PG8_SB(0, 1), b2 + hstep, voffB); PG8_STAGE(PG8_SA(0, 0), a2, voffA);
            PG8_WAIT_V(8); PG8_WAIT_L(0); PG8_BAR; PG8_MMA(1, 0, At, B0); PG8_MMA(1, 1, At, B1); PG8_BAR; PG8_SCHED;
            PG8_LDB(B0, 1, 0); PG8_LDB(B1, 1, 1); PG8_SCHED; PG8_LDA(At, 1, 0); PG8_STAGE(PG8_SA(0, 1), a2 + hstep, voffA);
            PG8_WAIT_V(8); PG8_WAIT_L(0); PG8_BAR; PG8_MMA(0, 0, At, B0); PG8_MMA(0, 1, At, B1); PG8_BAR; PG8_SCHED;
            PG8_LDA(At, 1, 1); PG8_STAGE(PG8_SB(1, 0), b3, voffB); PG8_STAGE(PG8_SB(1, 1), b3 + hstep, voffB); PG8_STAGE(PG8_SA(1, 0), a3, voffA);
            PG8_WAIT_V(8); PG8_WAIT_L(0); PG8_BAR; PG8_MMA(1, 0, At, B0); PG8_MMA(1, 1, At, B1); PG8_BAR; PG8_SCHED;
            } else {
            PG8_LDB(B0, 0, 0); PG8_SCHED; PG8_LDA(At, 0, 0); PG8_STAGE(PG8_SA(1, 1), a1 + hstep, voffA);
            PG8_WAIT_L(8); PG8_BAR; PG8_WAIT_L(0); PG8_MMA(0, 0, At, B0); PG8_BAR; PG8_SCHED;
            PG8_LDB(B1, 0, 1); PG8_STAGE(PG8_SB(0, 0), b2, voffB);
            PG8_BAR; PG8_WAIT_L(0); PG8_MMA(0, 1, At, B1); PG8_BAR;
            PG8_LDA(At, 0, 1); PG8_STAGE(PG8_SA(0, 0), a2, voffA);
            PG8_BAR; PG8_WAIT_L(0); PG8_MMA(1, 0, At, B0); PG8_BAR; PG8_SCHED;
            PG8_STAGE(PG8_SB(0, 1), b2 + hstep, voffB);
            PG8_WAIT_V(6); PG8_BAR; PG8_MMA(1, 1, At, B1); PG8_BAR;
            PG8_LDB(B0, 1, 0); PG8_SCHED; PG8_LDA(At, 1, 0); PG8_STAGE(PG8_SA(0, 1), a2 + hstep, voffA);
            PG8_WAIT_L(8); PG8_BAR; PG8_WAIT_L(0); PG8_MMA(0, 0, At, B0); PG8_BAR; PG8_SCHED;
            PG8_LDB(B1, 1, 1); PG8_STAGE(PG8_SB(1, 0), b3, voffB);
            PG8_BAR; PG8_WAIT_L(0); PG8_MMA(0, 1, At, B1); PG8_BAR;
            PG8_LDA(At, 1, 1); PG8_STAGE(PG8_SA(1, 0), a3, voffA);
            PG8_BAR; PG8_WAIT_L(0); PG8_MMA(1, 0, At, B0); PG8_BAR; PG8_SCHED;
            PG8_STAGE(PG8_SB(1, 1), b3 + hstep, voffB);
            PG8_WAIT_V(6); PG8_BAR; PG8_MMA(1, 1, At, B1); PG8_BAR;
            }
        }
        if constexpr (ALIGN_EPI) { if (wr == 0) PG8_BAR; }
        if constexpr (!Epi::AFTER_DRAIN) { E(acc, cur, wr, wc, fr, fq);
#if defined(PROBE_EPI2)
            if constexpr (Epi::IDEMP) { asm volatile("" ::: "memory"); E(acc, cur, wr, wc, fr, fq); }
#endif
            S.done(cur); }
        if (!has_next) break;
#pragma unroll
        for (int a = 0; a < 2; ++a)
#pragma unroll
            for (int b = 0; b < 2; ++b)
#pragma unroll
                for (int m = 0; m < 4; ++m)
#pragma unroll
                    for (int n = 0; n < 2; ++n) acc[a][b][m][n] = (f32x4){0.f, 0.f, 0.f, 0.f};
        cur = nxt; cA = nA; cB = nB; ++ui;
        if constexpr (ALIGN_EPI) { if (wr == 1) PG8_BAR; }
    }
    PG8_WAIT_V(0);
    if constexpr (!ALIGN_EPI) { if (wr == 0) PG8_BAR; }
    PG8_BAR;
    if constexpr (Epi::AFTER_DRAIN) { E.fused(acc, cur, wr, wc, fr, fq, lds, wid, lane); S.done(cur); }
#undef PG8_SA
#undef PG8_SB
#undef PG8_STAGE
#undef PG8_LDA
#undef PG8_LDB
#undef PG8_MMA
#undef PG8_WAIT_V
#undef PG8_WAIT_L
#undef PG8_BAR
#undef PG8_SCHED
}
}

#define LAS __attribute__((address_space(3)))
typedef unsigned short bf16;
typedef float f32x4 __attribute__((ext_vector_type(4)));
typedef unsigned u32x4 __attribute__((ext_vector_type(4)));
typedef unsigned u32x2 __attribute__((ext_vector_type(2)));
typedef short bf16x8 __attribute__((ext_vector_type(8)));
typedef short s16x4 __attribute__((ext_vector_type(4)));

constexpr int DM = 1024, NB = 16, SEQ = 4096, MP = NB * SEQ, SBATCH = 32, SSEQ = 16, MS = SBATCH * SSEQ, MT = MP + MS;
constexpr int DFF = 2816, DIN = 5632, ZA_W = 3584, ZG_W = 2048;
constexpr int NKV = 4, HD = 64, CW = 128;
constexpr float EPS = 1e-6f;
constexpr int NWAVES = 8, NTHREADS = 512;
constexpr int N_PHASES = 10;

constexpr size_t O_YP = 0, O_YS = 67108864, O_KP = O_YS + 524288, O_VP = O_KP + 524288, O_CP = O_VP + 524288, O_LP = O_CP + 49152,
                 O_KS = O_LP + 16384, O_VS = O_KS + 131072, O_CS = O_VS + 131072, O_LS = O_CS + 98304, O_END = O_LS + 32768;
constexpr size_t MiB = 1u << 20;
constexpr size_t WS_WGU1 = 0, WS_WD1 = 11 * MiB, WS_WIN = 17 * MiB, WS_WBR = 28 * MiB, WS_WBA = 30 * MiB, WS_WOUT = 32 * MiB, WS_WGU2 = 34 * MiB, WS_WD2 = 45 * MiB,
                 WS_WRG = 51 * MiB, WS_WIG = 51 * MiB + 512 * 1024, WS_SS1 = 52 * MiB, WS_SS2 = 57 * MiB, WS_SS3 = 62 * MiB, WS_SS0 = 778 * MiB + 130 * MiB  ,
                 WS_A = 68 * MiB  , WS_B = 520 * MiB  , WS_C = 778 * MiB  , WS_CTL = 916 * MiB  , WS_PART = 920 * MiB  , WS_END = 944 * MiB;
constexpr size_t CTL_ZERO_BYTES = 65536;
constexpr int LDS_BARST = 144000;
constexpr size_t OUT_H1 = 0, OUT_REC = (size_t)MT * DM * 2;
static_assert(OUT_REC * 2 == (O_KP) * 4, "h1 + rec fill exactly y_prompt + y_sample");
static_assert((size_t)MT * ZA_W * 2 <= WS_B - WS_A && (size_t)MT * ZG_W * 2 <= WS_C - WS_B && WS_C + (size_t)MT * DM * 2 <= WS_END, "ws map");
static_assert((size_t)MT * 16 * 4 <= 5 * MiB, "ss");

constexpr int LDS_BYTES = 147456;

__device__ __forceinline__ unsigned pk2(float lo, float hi) { return pg8::cvt_pk_bf16(lo, hi); }
__device__ __forceinline__ float bflo(unsigned w) { return __uint_as_float(w << 16); }
__device__ __forceinline__ float bfhi(unsigned w) { return __uint_as_float(w & 0xffff0000u); }
__device__ __forceinline__ float sigm(float x) { return __builtin_amdgcn_rcpf(1.f + __expf(-x)); }
__device__ __forceinline__ float gelu_tanh(float x) { const float u = 1.5957691216057308f * (x + 0.044715f * x * x * x); return x * sigm(u); }
__device__ __forceinline__ float silu(float x) { return x * sigm(x); }
typedef float f32x2 __attribute__((ext_vector_type(2)));
__device__ __forceinline__ f32x2 exp2_2(f32x2 t) { f32x2 e; e.x = __builtin_amdgcn_exp2f(t.x); e.y = __builtin_amdgcn_exp2f(t.y); return e; }
__device__ __forceinline__ f32x2 rcp_2(f32x2 d) { f32x2 r; r.x = __builtin_amdgcn_rcpf(d.x); r.y = __builtin_amdgcn_rcpf(d.y); return r; }
__device__ __forceinline__ f32x2 sigm2(f32x2 x) { return rcp_2(exp2_2(x * -1.4426950408889634f) + 1.0f); }
__device__ __forceinline__ unsigned silu_mul_pk(f32x2 g, f32x2 u) { const f32x2 o = (g * u) * sigm2(g); return pk2(o.x, o.y); }
__device__ __forceinline__ unsigned gelu_mul_pk(f32x2 g, f32x2 h) {
    const f32x2 t = (g * g) * (0.044715f * 1.5957691216057308f) + 1.5957691216057308f, u = g * t;
    const f32x2 r = rcp_2(exp2_2(u * -1.4426950408889634f) + 1.0f), o = (g * h) * r; return pk2(o.x, o.y); }
__device__ __forceinline__ float wave_sum(float v) {
#pragma unroll
    for (int o = 1; o < 64; o <<= 1) v += __shfl_xor(v, o);
    return v;
}
__device__ __forceinline__ float rowscale(const float* ss, int row) {
    const f32x4* p = (const f32x4*)(ss + (size_t)row * 16);
    const f32x4 a = p[0], b = p[1], c = p[2], d = p[3];
    const float s = (((a.x + a.y) + (a.z + a.w)) + ((b.x + b.y) + (b.z + b.w))) + (((c.x + c.y) + (c.z + c.w)) + ((d.x + d.y) + (d.z + d.w)));
    return rsqrtf(s * (1.f / 1024.f) + EPS);
}
#define LDS_WAIT() asm volatile("s_waitcnt lgkmcnt(0)" ::: "memory")

typedef pg8::Unit Unit;
__device__ __forceinline__ float rs_from_quarter(f32x4 q) { float s = (q.x + q.y) + (q.z + q.w); s += __shfl_xor(s, 16); s += __shfl_xor(s, 32); return rsqrtf(s * (1.f / 1024.f) + EPS); }
#define UNPK8(W_, LO_, HI_) do { const u32x4 w__ = (W_); LO_ = (f32x4){bflo(w__.x), bfhi(w__.x), bflo(w__.y), bfhi(w__.y)}; HI_ = (f32x4){bflo(w__.z), bfhi(w__.z), bflo(w__.w), bfhi(w__.w)}; } while (0)
#define PK8(W_, LO_, HI_) do { u32x4 w__; w__.x = pk2((LO_)[0], (LO_)[1]); w__.y = pk2((LO_)[2], (LO_)[3]); w__.z = pk2((HI_)[0], (HI_)[1]); w__.w = pk2((HI_)[2], (HI_)[3]); W_ = w__; } while (0)
template <bool SCALE> struct EpiSwiGLU {
    static constexpr bool PERM = true, AFTER_DRAIN = false, IDEMP = true; static constexpr int NST = 8;
    bf16* O; const float* ss;
    __device__ __forceinline__ void operator()(const f32x4 (&acc)[2][2][4][2], const Unit& u, int wr, int wc, int fr, int fq) const {
        const int row0 = u.pm * 256 + wr * 64 + fr, col = u.pn * 128 + wc * 32 + 8 * fq;
        f32x4 sq[2][4];
        if (SCALE) {
#pragma unroll
            for (int ai = 0; ai < 2; ++ai)
#pragma unroll
                for (int m = 0; m < 4; ++m) sq[ai][m] = *(const f32x4*)(ss + (size_t)(row0 + ai * 128 + m * 16) * 16 + 4 * fq);
        }
#pragma unroll
        for (int ai = 0; ai < 2; ++ai)
#pragma unroll
            for (int m = 0; m < 4; ++m) {
                const int row = row0 + ai * 128 + m * 16;
                float rs = 1.f; if (SCALE) rs = rs_from_quarter(sq[ai][m]);
                const f32x4 g0 = acc[ai][0][m][0] * rs, g1 = acc[ai][0][m][1] * rs, u0 = acc[ai][1][m][0] * rs, u1 = acc[ai][1][m][1] * rs;
                u32x4 w;
                w.x = silu_mul_pk((f32x2){g0[0], g0[1]}, (f32x2){u0[0], u0[1]}); w.y = silu_mul_pk((f32x2){g0[2], g0[3]}, (f32x2){u0[2], u0[3]});
                w.z = silu_mul_pk((f32x2){g1[0], g1[1]}, (f32x2){u1[0], u1[1]}); w.w = silu_mul_pk((f32x2){g1[2], g1[3]}, (f32x2){u1[2], u1[3]});
                *(u32x4*)(O + (size_t)row * DFF + col) = w;
            }
    }
};
template <bool RES_BF16, bool OUT_F32> struct EpiRes {
    static constexpr bool PERM = true, AFTER_DRAIN = false, IDEMP = true; static constexpr int NST = OUT_F32 ? 32 : 16;
    const void* res; const float* res_s;
    void* out; float* ss; float fac;
    __device__ __forceinline__ void operator()(const f32x4 (&acc)[2][2][4][2], const Unit& u, int wr, int wc, int fr, int fq) const {
        const int row0 = u.pm * 256 + wr * 64 + fr, col0 = u.pn * 256 + wc * 32 + 8 * fq;
#pragma unroll
        for (int ai = 0; ai < 2; ++ai) {
            u32x4 rw[2][4][2];
            if (RES_BF16) {
#pragma unroll
                for (int m = 0; m < 4; ++m)
#pragma unroll
                    for (int bj = 0; bj < 2; ++bj) rw[ai][m][bj] = *(const u32x4*)((const bf16*)res + (size_t)(row0 + ai * 128 + m * 16) * DM + col0 + bj * 128);
            }
            f32x4 rf[4][2][2];
            if (!RES_BF16) {
                const float* rbase = (u.pm < MP / 256) ? (const float*)res + (size_t)(row0 + ai * 128) * DM + col0 : res_s + (size_t)(row0 + ai * 128 - MP) * DM + col0;
#pragma unroll
                for (int m = 0; m < 4; ++m)
#pragma unroll
                    for (int bj = 0; bj < 2; ++bj) { rf[m][bj][0] = *(const f32x4*)(rbase + (size_t)m * 16 * DM + bj * 128); rf[m][bj][1] = *(const f32x4*)(rbase + (size_t)m * 16 * DM + bj * 128 + 4); }
            }
#pragma unroll
            for (int m = 0; m < 4; ++m) {
                const int row = row0 + ai * 128 + m * 16; float sq = 0.f;
#pragma unroll
                for (int bj = 0; bj < 2; ++bj) {
                    const int col = col0 + bj * 128; f32x4 r0, r1;
                    if (RES_BF16) { UNPK8(rw[ai][m][bj], r0, r1); } else { r0 = rf[m][bj][0]; r1 = rf[m][bj][1]; }
                    const f32x4 v0 = r0 + acc[ai][bj][m][0] * fac, v1 = r1 + acc[ai][bj][m][1] * fac;
                    sq += (v0[0] * v0[0] + v0[1] * v0[1]) + (v0[2] * v0[2] + v0[3] * v0[3]) + (v1[0] * v1[0] + v1[1] * v1[1]) + (v1[2] * v1[2] + v1[3] * v1[3]);
                    if (OUT_F32) { float* op = (float*)out + (size_t)row * DM + col; *(f32x4*)op = v0; *(f32x4*)(op + 4) = v1; }
                    else { u32x4 w; PK8(w, v0, v1); *(u32x4*)((bf16*)out + (size_t)row * DM + col) = w; }
                }
                sq += __shfl_xor(sq, 16); sq += __shfl_xor(sq, 32);
                if (fq == 0) ss[(size_t)row * 16 + u.pn * 4 + wc] = sq;
            }
        }
    }
};
struct EpiWin {
    static constexpr bool PERM = true, AFTER_DRAIN = false, IDEMP = true; static constexpr int NST = 16;
    bf16* zA; bf16* zG; const float* ss;
    __device__ __forceinline__ void operator()(const f32x4 (&acc)[2][2][4][2], const Unit& u, int wr, int wc, int fr, int fq) const {
        const int row0 = u.pm * 256 + wr * 64 + fr;
        const bool gate = (u.pn >= 14);
        bf16* base = gate ? zG : zA; const int ld = gate ? ZG_W : ZA_W;
        const int col0 = (gate ? (u.pn - 14) * 256 : u.pn * 256) + wc * 32 + 8 * fq;
        f32x4 sq[2][4];
#pragma unroll
        for (int ai = 0; ai < 2; ++ai)
#pragma unroll
            for (int m = 0; m < 4; ++m) sq[ai][m] = *(const f32x4*)(ss + (size_t)(row0 + ai * 128 + m * 16) * 16 + 4 * fq);
#pragma unroll
        for (int ai = 0; ai < 2; ++ai)
#pragma unroll
            for (int m = 0; m < 4; ++m) {
                const int row = row0 + ai * 128 + m * 16; const float rs = rs_from_quarter(sq[ai][m]);
#pragma unroll
                for (int bj = 0; bj < 2; ++bj) {
                    f32x4 v0 = acc[ai][bj][m][0] * rs, v1 = acc[ai][bj][m][1] * rs;
                    if (gate) { const f32x2 a0 = sigm2((f32x2){v0[0], v0[1]}), a1 = sigm2((f32x2){v0[2], v0[3]}), b0 = sigm2((f32x2){v1[0], v1[1]}), b1 = sigm2((f32x2){v1[2], v1[3]});
                        v0 = (f32x4){a0.x, a0.y, a1.x, a1.y}; v1 = (f32x4){b0.x, b0.y, b1.x, b1.y}; }
                    u32x4 w; PK8(w, v0, v1);
                    *(u32x4*)(base + (size_t)row * ld + col0 + bj * 128) = w;
                }
            }
    }
};
template <bool ADD> struct EpiBranch {
    static constexpr bool PERM = true, AFTER_DRAIN = false, IDEMP = !ADD; static constexpr int NST = 16;
    bf16* mg; const bf16* zG; int goff;
    __device__ __forceinline__ void operator()(const f32x4 (&acc)[2][2][4][2], const Unit& u, int wr, int wc, int fr, int fq) const {
        const int row0 = u.pm * 256 + wr * 64 + fr, col0 = u.pn * 256 + wc * 32 + 8 * fq;
#pragma unroll
        for (int ai = 0; ai < 2; ++ai) {
            u32x4 gw[4][2], tw[4][2];
#pragma unroll
            for (int m = 0; m < 4; ++m)
#pragma unroll
                for (int bj = 0; bj < 2; ++bj) {
                    const size_t row = (size_t)(row0 + ai * 128 + m * 16);
                    gw[m][bj] = *(const u32x4*)(zG + row * ZG_W + goff + col0 + bj * 128);
                    if (ADD) tw[m][bj] = *(const u32x4*)(mg + row * DM + col0 + bj * 128);
                }
#pragma unroll
            for (int m = 0; m < 4; ++m)
#pragma unroll
                for (int bj = 0; bj < 2; ++bj) {
                    const size_t row = (size_t)(row0 + ai * 128 + m * 16);
                    f32x4 g0, g1; UNPK8(gw[m][bj], g0, g1);
                    f32x4 v0 = acc[ai][bj][m][0] * g0, v1 = acc[ai][bj][m][1] * g1;
                    if (ADD) { f32x4 t0, t1; UNPK8(tw[m][bj], t0, t1); v0 += t0; v1 += t1; }
                    u32x4 w; PK8(w, v0, v1);
                    *(u32x4*)(mg + row * DM + col0 + bj * 128) = w;
                }
        }
    }
};

template <int NN, int NS, int KS> struct SplitOrder {
    int G, c;
    __device__ __forceinline__ bool next(int i, Unit& u) const {
        const int L = i * G + c; if (L >= 2 * NN * NS) return false;
        const int sl = L / (2 * NN), r = L % (2 * NN); u.pm = MP / 256 + r / NN; u.pn = r % NN; u.ko = sl * KS; u.nt = KS / 64; return true;
    }
    __device__ __forceinline__ void a_ready(const Unit&) const {}
    __device__ __forceinline__ void done(const Unit&) const {}
};
template <int NN, int KS> struct EpiPartial {
    static constexpr bool PERM = true, AFTER_DRAIN = false, IDEMP = true; static constexpr int NST = 32;
    f32x4* P;
    __device__ __forceinline__ void operator()(const f32x4 (&acc)[2][2][4][2], const Unit& u, int wr, int wc, int fr, int fq) const {
        const int tl = (u.pm - MP / 256) * NN + u.pn, sl = u.ko / KS;
        const int tid_ = ((wr * 4 + wc) * 4 + fq) * 16 + fr;
        f32x4* base = P + ((size_t)(sl * 2 * NN + tl) * 512 + tid_) * 32;
#pragma unroll
        for (int ai = 0; ai < 2; ++ai)
#pragma unroll
            for (int bj = 0; bj < 2; ++bj)
#pragma unroll
                for (int m = 0; m < 4; ++m)
#pragma unroll
                    for (int n = 0; n < 2; ++n) base[(((ai * 2 + bj) * 4 + m) * 2 + n)] = acc[ai][bj][m][n];
    }
};
template <int NN, int NS, int KS> struct ComboOrder {
    pg8::StaticOrder so; SplitOrder<NN, NS, KS> sp; int rounds;
    __device__ __forceinline__ bool next(int i, Unit& u) const { if (i < rounds) return so.next(i, u); return sp.next(i - rounds, u); }
    __device__ __forceinline__ void a_ready(const Unit&) const {}
    __device__ __forceinline__ void done(const Unit&) const {}
};
template <int NN, int KS> struct EpiResSplit {
    static constexpr bool PERM = true, AFTER_DRAIN = false, IDEMP = true; static constexpr int NST = 16;
    EpiRes<true, false> R; EpiPartial<NN, KS> Pp;
    __device__ __forceinline__ void operator()(const f32x4 (&acc)[2][2][4][2], const Unit& u, int wr, int wc, int fr, int fq) const { if (u.nt) Pp(acc, u, wr, wc, fr, fq); else R(acc, u, wr, wc, fr, fq); }
};
template <int NS>
__device__ __forceinline__ void splitk_fixup_res(const bf16* res, bf16* out, float* ss, float fac, const f32x4* P, int nN, int G, int wid_s) {
    const int lane = (int)__builtin_amdgcn_mbcnt_hi(~0u, __builtin_amdgcn_mbcnt_lo(~0u, 0u)), wid = wid_s, tid = wid * 64 + lane, wr = wid >> 2, wc = wid & 3, fr = lane & 15, fq = lane >> 4;
    const size_t sstride = (size_t)(2 * nN) * 512 * 32;
    for (int w = blockIdx.x; w < 2 * nN * 8; w += G) {
        const int tl = w >> 3, am = w & 7, pm = MP / 256 + tl / nN, pn = tl % nN;
        const f32x4* base = P + ((size_t)tl * 512 + tid) * 32;
        const int ai = am >> 2, m = am & 3, row = pm * 256 + ai * 128 + wr * 64 + m * 16 + fr; float sq = 0.f;
#pragma unroll 1
        for (int bn = 0; bn < 4; ++bn) {
            const int bj = bn >> 1, n = bn & 1, col = pn * 256 + bj * 128 + wc * 32 + 8 * fq + 4 * n;
            const f32x4* pj = base + (((ai * 2 + bj) * 4 + m) * 2 + n);
            const u32x2 rw = *(const u32x2*)(res + (size_t)row * DM + col);
            f32x4 part[NS];
#pragma unroll
            for (int sl = 0; sl < NS; ++sl) part[sl] = pj[(size_t)sl * sstride];
            f32x4 sum = part[0];
#pragma unroll
            for (int sl = 1; sl < NS; ++sl) sum += part[sl];
            const f32x4 v = (f32x4){bflo(rw.x), bfhi(rw.x), bflo(rw.y), bfhi(rw.y)} + sum * fac;
            sq += (v[0] * v[0] + v[1] * v[1]) + (v[2] * v[2] + v[3] * v[3]);
            u32x2 wv; wv.x = pk2(v[0], v[1]); wv.y = pk2(v[2], v[3]);
            *(u32x2*)(out + (size_t)row * DM + col) = wv;
        }
        sq += __shfl_xor(sq, 16); sq += __shfl_xor(sq, 32);
        if (fq == 0) ss[(size_t)row * 16 + pn * 4 + wc] = sq;
    }
}

struct SkewOrder {
    int nM, nN, G, c, start, count, eighth;
    __device__ __forceinline__ void init(int M, int N, int G_, int c_) {
        nM = M / 256; nN = N / 256; G = G_; c = c_; const int nwg = nM * nN;
        if ((G & 7) == 0) { eighth = G >> 3; const int x = c & 7, full = nwg / G, rem = nwg % G; int st = 0, cnt = 0;
            for (int y = 0; y <= x; ++y) { int e = rem - y * eighth; e = e < 0 ? 0 : (e > eighth ? eighth : e); cnt = full * eighth + e; if (y < x) st += cnt; }
            start = st; count = cnt; }
        else { eighth = 0; start = 0; count = nwg; }
    }
    __device__ __forceinline__ bool next(int i, Unit& u) const {
        const int off = eighth ? i * eighth + (c >> 3) : i * G + c; if (off >= count) return false;
        const int wgid = start + off, nig = 8 * nN, gid = wgid / nig, fm = gid * 8, gsz = (nM - fm) < 8 ? (nM - fm) : 8;
        u.pm = fm + ((wgid % nig) % gsz); u.pn = (wgid % nig) / gsz; u.ko = 0; u.nt = 0; return true;
    }
    __device__ __forceinline__ void a_ready(const Unit&) const {}
    __device__ __forceinline__ void done(const Unit&) const {}
    __device__ __forceinline__ void delay(int ticks_per_eighth) const {
        if (!eighth) return;
        const unsigned long long d_ = (unsigned long long)((c & 7) * ticks_per_eighth), t0_ = __builtin_amdgcn_s_memrealtime();
        while (__builtin_amdgcn_s_memrealtime() - t0_ < d_) __builtin_amdgcn_s_sleep(2);
    }
};

struct Args { const float* in[27]; float* out; unsigned char* ws; int ph_lo, ph_hi, coop, pad; };
enum { I_XP = 0, I_XS, I_CK, I_CV, I_SCONV, I_SLRU, I_NFF1, I_F1G, I_F1U, I_F1D, I_NMIX, I_WIN, I_CONVW, I_CONVB, I_WRG, I_BRG, I_WIG, I_BIG, I_LAM, I_SINK, I_WBR, I_WOUT, I_NFF2, I_F2G, I_F2U, I_F2D, I_NFIN };

__device__ __forceinline__ void transpose_item(const float* W, int N, bf16* dst, int dpitch, const float* fold, LAS float* scr, int k0, int n0, int dst_row0, int dk0, int lane) {
    float tv[32];
#pragma unroll
    for (int i = 0; i < 32; ++i) tv[i] = W[(size_t)(k0 + 2 * i + (lane >> 5)) * N + n0 + (lane & 31)];
#pragma unroll
    for (int i = 0; i < 32; ++i) { const int kk = 2 * i + (lane >> 5); float v = tv[i]; if (fold) v *= fold[k0 + kk]; scr[kk * 33 + (lane & 31)] = v; }
    LDS_WAIT(); asm volatile("" ::: "memory");
    const int c = lane & 7;
#pragma unroll
    for (int j = 0; j < 4; ++j) { const int n = (lane >> 3) + 8 * j; const LAS float* s = scr + (8 * c) * 33 + n;
        u32x4 o; o.x = pk2(s[0 * 33], s[1 * 33]); o.y = pk2(s[2 * 33], s[3 * 33]); o.z = pk2(s[4 * 33], s[5 * 33]); o.w = pk2(s[6 * 33], s[7 * 33]);
        *(u32x4*)(dst + (size_t)(dst_row0 + n) * dpitch + dk0 + 8 * c) = o; }
    LDS_WAIT(); asm volatile("" ::: "memory");
}
#define TJOB(SRC, NN, KK, DST, FOLD, MODE) { constexpr int ni_ = ((KK) / 64) * ((NN) / 32); if (r < ni_) { constexpr int nblk_ = (NN) / 32; const int kb_ = r / nblk_, n0_ = (r % nblk_) * 32; \
        const int dr0_ = ((MODE) == 0) ? n0_ : (256 * (n0_ / 128) + (n0_ % 128) + ((MODE) == 2 ? 128 : 0)); transpose_item((SRC), (NN), (DST), (KK), (FOLD), scr, kb_ * 64, n0_, dr0_, kb_ * 64, lane); continue; } r -= ni_; }
__device__ __forceinline__ void p0_prologue(const Args& a, LAS unsigned char* lds, int G) {
    const int tid = threadIdx.x, lane = tid & 63, wave = tid >> 6;
    LAS float* scr = (LAS float*)(lds + wave * 16384);
    const int gw = blockIdx.x * NWAVES + wave, NGW = G * NWAVES;
    unsigned char* ws = a.ws;
    constexpr int NITEMS = 6 * 1408 + 2816 + 3 * 512 + 2 * 64;
    for (int it = gw; it < NITEMS; it += NGW) {
        int r = it;
        TJOB(a.in[I_F1G], DFF, DM, (bf16*)(ws + WS_WGU1), a.in[I_NFF1], 1)
        TJOB(a.in[I_F1U], DFF, DM, (bf16*)(ws + WS_WGU1), a.in[I_NFF1], 2)
        TJOB(a.in[I_F1D], DM, DFF, (bf16*)(ws + WS_WD1), (const float*)nullptr, 0)
        TJOB(a.in[I_WIN], DIN, DM, (bf16*)(ws + WS_WIN), a.in[I_NMIX], 0)
        TJOB(a.in[I_WBR], DM, DM, (bf16*)(ws + WS_WBR), (const float*)nullptr, 0)
        TJOB(a.in[I_WBR] + (size_t)DM * DM, DM, DM, (bf16*)(ws + WS_WBA), (const float*)nullptr, 0)
        TJOB(a.in[I_WOUT], DM, DM, (bf16*)(ws + WS_WOUT), (const float*)nullptr, 0)
        TJOB(a.in[I_F2G], DFF, DM, (bf16*)(ws + WS_WGU2), a.in[I_NFF2], 1)
        TJOB(a.in[I_F2U], DFF, DM, (bf16*)(ws + WS_WGU2), a.in[I_NFF2], 2)
        TJOB(a.in[I_F2D], DM, DFF, (bf16*)(ws + WS_WD2), (const float*)nullptr, 0)
        { if (r < 64) { const int kb = r >> 2, n0 = (r & 3) * 32; transpose_item(a.in[I_WRG], 128, (bf16*)(ws + WS_WRG), 128, nullptr, scr, kb * 64, n0, (kb >> 1) * 128 + n0, (kb & 1) * 64, lane); continue; } r -= 64; }
        { const int kb = r >> 2, n0 = (r & 3) * 32; transpose_item(a.in[I_WIG], 128, (bf16*)(ws + WS_WIG), 128, nullptr, scr, kb * 64, n0, (kb >> 1) * 128 + n0, (kb & 1) * 64, lane); }
    }
    bf16* xn = (bf16*)(ws + WS_B);
    float* ss0 = (float*)(ws + WS_SS0);
    for (int m0 = gw; m0 < MT; m0 += 2 * NGW) {
        const int m1 = (m0 + NGW < MT) ? m0 + NGW : m0;
        const float* xr0 = (m0 < MP) ? a.in[I_XP] + (size_t)m0 * DM : a.in[I_XS] + (size_t)(m0 - MP) * DM;
        const float* xr1 = (m1 < MP) ? a.in[I_XP] + (size_t)m1 * DM : a.in[I_XS] + (size_t)(m1 - MP) * DM;
        f32x4 v0[4], v1[4]; float s0 = 0.f, s1 = 0.f;
#pragma unroll
        for (int j = 0; j < 4; ++j) { v0[j] = ((const f32x4*)xr0)[lane + 64 * j]; v1[j] = ((const f32x4*)xr1)[lane + 64 * j]; }
#pragma unroll
        for (int j = 0; j < 4; ++j) { s0 += (v0[j].x * v0[j].x + v0[j].y * v0[j].y) + (v0[j].z * v0[j].z + v0[j].w * v0[j].w); s1 += (v1[j].x * v1[j].x + v1[j].y * v1[j].y) + (v1[j].z * v1[j].z + v1[j].w * v1[j].w); }
        s0 = wave_sum(s0); s1 = wave_sum(s1);
        if (lane < 16) { ss0[(size_t)m0 * 16 + lane] = (lane == 0) ? s0 : 0.f; ss0[(size_t)m1 * 16 + lane] = (lane == 0) ? s1 : 0.f; }
        unsigned long long* o0 = (unsigned long long*)(xn + (size_t)m0 * DM) + lane; unsigned long long* o1 = (unsigned long long*)(xn + (size_t)m1 * DM) + lane;
#pragma unroll
        for (int j = 0; j < 4; ++j) {
            o0[64 * j] = (unsigned long long)pk2(v0[j].x, v0[j].y) | ((unsigned long long)pk2(v0[j].z, v0[j].w) << 32);
            o1[64 * j] = (unsigned long long)pk2(v1[j].x, v1[j].y) | ((unsigned long long)pk2(v1[j].z, v1[j].w) << 32); }
    }
}

constexpr int RC_CB = 0, RC_CF = 17408, RC_HS = 51200, RC_EX = 68608;
template <bool PROMPT>
__device__ __forceinline__ void rec_unit(const Args& a, LAS unsigned char* lds, const int b, const int cg) {
    const int tid = threadIdx.x, lane = tid & 63, wave = __builtin_amdgcn_readfirstlane(tid >> 6), fr = lane & 15, fq = lane >> 4, cgw = wave & 3, th = wave >> 2;
    const bf16* zA = (const bf16*)(a.ws + WS_A);
    bf16* rec = (bf16*)((unsigned char*)a.out + OUT_REC);
    LAS bf16* Cb = (LAS bf16*)(lds + RC_CB); LAS float* Hs = (LAS float*)(lds + RC_HS); LAS float* EX = (LAS float*)(lds + RC_EX);
    {
        constexpr int T = PROMPT ? SEQ : SSEQ;
        const int row0 = PROMPT ? b * SEQ : MP + b * SSEQ;
        const float* conv_prev = PROMPT ? nullptr : a.in[I_SCONV] + (size_t)b * 3 * DM;
        const float* h0 = PROMPT ? nullptr : a.in[I_SLRU] + (size_t)b * DM;
        float* o_conv = a.out + (PROMPT ? O_CP : O_CS) + (size_t)b * 3 * DM;
        float* o_lru = a.out + (PROMPT ? O_LP : O_LS) + (size_t)b * DM;
        const int n = cg >> 1;
        const int chl = cgw * 16 + fr, c = cg * 64 + chl, e = (cg & 1) * 64 + chl;
        bf16x8 Br[4], Bi[4];
        { const bf16* wr_ = (const bf16*)(a.ws + WS_WRG) + (size_t)n * 16384 + e * 128 + 8 * fq; const bf16* wi_ = (const bf16*)(a.ws + WS_WIG) + (size_t)n * 16384 + e * 128 + 8 * fq;
#pragma unroll
          for (int ks = 0; ks < 4; ++ks) { Br[ks] = *(const bf16x8*)(wr_ + 32 * ks); Bi[ks] = *(const bf16x8*)(wi_ + 32 * ks); } }
        const float bias_r = a.in[I_BRG][c], bias_i = a.in[I_BIG][c];
        const float lam = a.in[I_LAM][c];
        const float sp = (lam < 0.f) ? (-lam + log1pf(expf(lam))) : log1pf(expf(-lam));
        const float sp8l = -8.f * sp * 1.4426950408889634f;
        float h = h0 ? h0[c] : 0.f;
        const int cp2 = 2 * lane, cch = n * 128 + cp2, tg8 = 8 * wave;
        f32x2 cw2[4];
#pragma unroll
        for (int j = 0; j < 4; ++j) cw2[j] = *(const f32x2*)(a.in[I_CONVW] + j * DM + cch);
        const f32x2 cb2 = *(const f32x2*)(a.in[I_CONVB] + cch);
        const int nchunks = (T + 63) / 64;
        unsigned xq[11];
#define REC_LOADX(CK) do { const int tb_ = (CK) * 64 + tg8 - 3; \
            _Pragma("unroll") for (int rr = 0; rr < 11; ++rr) { int trc_ = tb_ + rr; trc_ = trc_ < 0 ? 0 : trc_; trc_ = trc_ > T - 1 ? T - 1 : trc_; \
                xq[rr] = *(const unsigned*)(zA + (size_t)(row0 + trc_) * ZA_W + cch); } \
            if (conv_prev && (CK) == 0 && wave == 0) { _Pragma("unroll") for (int rr = 0; rr < 3; ++rr) { const f32x2 pv_ = *(const f32x2*)(conv_prev + (size_t)rr * DM + cch); xq[rr] = pk2(pv_.x, pv_.y); } } } while (0)
        REC_LOADX(0);
        for (int ck = 0; ck < nchunks; ++ck) {
            const int t0 = ck * 64, nt = PROMPT ? 64 : ((T - t0) < 64 ? (T - t0) : 64);
            {
                f32x2 xv[11];
#pragma unroll
                for (int rr = 0; rr < 11; ++rr) { unsigned w = xq[rr]; if (t0 + tg8 - 3 + rr < 0 && !conv_prev) w = 0u; xv[rr] = (f32x2){bflo(w), bfhi(w)}; }
#pragma unroll
                for (int i = 0; i < 8; ++i) {
                    f32x2 cv = cb2;
#pragma unroll
                    for (int j = 0; j < 4; ++j) cv += xv[i + j] * cw2[j];
                    if (tg8 + i >= nt) cv = (f32x2){0.f, 0.f};
                    *(LAS unsigned*)(Cb + (tg8 + i) * 136 + cp2) = pk2(cv.x, cv.y);
                }
            }
            if (ck + 1 < nchunks) REC_LOADX(ck + 1);
            const u32x4 gq = *(const u32x4*)(zA + (size_t)(row0 + (((tid >> 3) < nt) ? t0 + (tid >> 3) : t0)) * ZA_W + 1024 + cg * 64 + (tid & 7) * 8);
            __syncthreads();
            float av[2][4], bv[2][4], segA[2], segH[2];
#pragma unroll
            for (int mtl = 0; mtl < 2; ++mtl) {
                const int mt = 2 * th + mtl;
                f32x4 dr = (f32x4){0.f, 0.f, 0.f, 0.f}, di = (f32x4){0.f, 0.f, 0.f, 0.f};
                if (16 * mt < nt) {
#pragma unroll
                    for (int ks = 0; ks < 4; ++ks) { const bf16x8 af = *(const LAS bf16x8*)(Cb + (16 * mt + fr) * 136 + 32 * ks + 8 * fq);
                        dr = __builtin_amdgcn_mfma_f32_16x16x32_bf16(af, Br[ks], dr, 0, 0, 0); di = __builtin_amdgcn_mfma_f32_16x16x32_bf16(af, Bi[ks], di, 0, 0, 0); }
                }
                float A = 1.f, H = 0.f;
#pragma unroll
                for (int jp = 0; jp < 2; ++jp) {
                    const int tk0 = 16 * mt + 4 * fq + 2 * jp;
                    const f32x2 tr = __builtin_elementwise_min(((f32x2){dr[2 * jp], dr[2 * jp + 1]} + bias_r) * -1.4426950408889634f, (f32x2){60.f, 60.f});
                    const f32x2 ti = __builtin_elementwise_min(((f32x2){di[2 * jp], di[2 * jp + 1]} + bias_i) * -1.4426950408889634f, (f32x2){60.f, 60.f});
                    const f32x2 pr_ = exp2_2(tr) + 1.0f, pi_ = exp2_2(ti) + 1.0f, rc = rcp_2(pr_ * pi_);
                    const f32x2 r = pi_ * rc, ig = pr_ * rc;
                    const f32x2 la2 = r * sp8l;
                    f32x2 aa = exp2_2(la2);
                    const f32x2 y = la2 * 1.3862943611198906f;
                    f32x2 pp = y * (1.f / 120.f) + (1.f / 24.f); pp = pp * y + (1.f / 6.f); pp = pp * y + 0.5f; pp = pp * y + 1.0f;
                    const f32x2 omp = -(y * pp), oma = 1.0f - aa * aa;
                    f32x2 om; om.x = (y.x > -0.1f) ? omp.x : oma.x; om.y = (y.y > -0.1f) ? omp.y : oma.y;
                    f32x2 sq; sq.x = __builtin_amdgcn_sqrtf(om.x); sq.y = __builtin_amdgcn_sqrtf(om.y);
                    const f32x2 xc = (f32x2){__uint_as_float((unsigned)Cb[tk0 * 136 + e] << 16), __uint_as_float((unsigned)Cb[(tk0 + 1) * 136 + e] << 16)};
                    f32x2 bb = (sq * ig) * xc;
                    if (!PROMPT) { if (tk0 >= nt) { aa.x = 1.f; bb.x = 0.f; } if (tk0 + 1 >= nt) { aa.y = 1.f; bb.y = 0.f; } }
                    av[mtl][2 * jp] = aa.x; bv[mtl][2 * jp] = bb.x; H = aa.x * H + bb.x; A *= aa.x;
                    av[mtl][2 * jp + 1] = aa.y; bv[mtl][2 * jp + 1] = bb.y; H = aa.y * H + bb.y; A *= aa.y;
                }
                segA[mtl] = A; segH[mtl] = H;
            }
            float PA[2], PH[2], TA[2], TH[2];
#pragma unroll
            for (int mtl = 0; mtl < 2; ++mtl) {
                const float A0 = segA[mtl], H0 = segH[mtl];
                const float A1 = __shfl_xor(A0, 16), H1 = __shfl_xor(H0, 16);
                const bool up1 = (fq & 1) != 0;
                const float pairA = A0 * A1, pairH = up1 ? (A0 * H1 + H0) : (A1 * H0 + H1);
                const float p1A = up1 ? A1 : 1.f, p1H = up1 ? H1 : 0.f;
                const float qA = __shfl_xor(pairA, 32), qH = __shfl_xor(pairH, 32);
                const bool up2 = (fq & 2) != 0;
                TA[mtl] = pairA * qA; TH[mtl] = up2 ? (pairA * qH + pairH) : (qA * pairH + qH);
                PA[mtl] = up2 ? qA * p1A : p1A; PH[mtl] = up2 ? (p1A * qH + p1H) : p1H;
            }
            const float WA = TA[0] * TA[1], WH = TA[1] * TH[0] + TH[1];
            PH[1] = PA[1] * TH[0] + PH[1]; PA[1] = TA[0] * PA[1];
            if (fq == 0) { EX[((th * 4 + cgw) * 16 + fr) * 2 + 0] = WA; EX[((th * 4 + cgw) * 16 + fr) * 2 + 1] = WH; }
            __syncthreads();
            const float WA0 = EX[((0 * 4 + cgw) * 16 + fr) * 2 + 0], WH0 = EX[((0 * 4 + cgw) * 16 + fr) * 2 + 1], WA1 = EX[((1 * 4 + cgw) * 16 + fr) * 2 + 0], WH1 = EX[((1 * 4 + cgw) * 16 + fr) * 2 + 1];
            const float hmid = WA0 * h + WH0, hend = WA1 * hmid + WH1;
            const float hst = (th == 0) ? h : hmid;
#pragma unroll
            for (int mtl = 0; mtl < 2; ++mtl) {
                const int mt = 2 * th + mtl; float hc = PA[mtl] * hst + PH[mtl];
#pragma unroll
                for (int jj = 0; jj < 4; ++jj) { hc = av[mtl][jj] * hc + bv[mtl][jj]; Hs[(16 * mt + 4 * fq + jj) * 68 + chl] = hc; }
            }
            h = hend;
            __syncthreads();
            { const int tk = tid >> 3, c8 = (tid & 7) * 8;
              if (tk < nt) {
                const size_t row = (size_t)(row0 + t0 + tk);
                const u32x4 gw = gq;
                const f32x4 h0v = *(const LAS f32x4*)(Hs + tk * 68 + c8), h1v = *(const LAS f32x4*)(Hs + tk * 68 + c8 + 4);
                u32x4 w; w.x = gelu_mul_pk((f32x2){bflo(gw.x), bfhi(gw.x)}, (f32x2){h0v.x, h0v.y}); w.y = gelu_mul_pk((f32x2){bflo(gw.y), bfhi(gw.y)}, (f32x2){h0v.z, h0v.w});
                w.z = gelu_mul_pk((f32x2){bflo(gw.z), bfhi(gw.z)}, (f32x2){h1v.x, h1v.y}); w.w = gelu_mul_pk((f32x2){bflo(gw.w), bfhi(gw.w)}, (f32x2){h1v.z, h1v.w});
                *(u32x4*)(rec + row * DM + cg * 64 + c8) = w;
              } }
        }
#undef REC_LOADX
        if (th == 0 && fq == 0) o_lru[c] = h;
        if (tid < 192) { const int j = tid >> 6, ch = tid & 63; const unsigned w = zA[(size_t)(row0 + T - 3 + j) * ZA_W + cg * 64 + ch]; o_conv[j * DM + cg * 64 + ch] = __uint_as_float(w << 16); }
        __syncthreads();
    }
}
__device__ __forceinline__ void rec_phase(const Args& a, LAS unsigned char* lds, int G) {
    for (int u = blockIdx.x; u < 768; u += G) { if (u < 256) rec_unit<true>(a, lds, u >> 4, u & 15); else rec_unit<false>(a, lds, (u - 256) >> 4, (u - 256) & 15); }
}
constexpr int AT_KS = 0, AT_VT = 27648;
template <int NBLK, bool FULL = false>
__device__ __forceinline__ void attn_block(bf16* att, LAS bf16* Ks, LAS bf16* Vt, size_t qrow0, int hh, float sink, const bf16x8 (&q)[2][2], unsigned vst_, unsigned vval_, int fr, int fq) {
    const unsigned vst = FULL ? 0xFFFu : vst_, vval = FULL ? 0xFFFu : vval_;
    f32x4 st[NBLK][12];
#pragma unroll
    for (int kt = 0; kt < 12; ++kt) {
#pragma unroll
        for (int bi = 0; bi < NBLK; ++bi) st[bi][kt] = (f32x4){0.f, 0.f, 0.f, 0.f};
        if ((vst >> kt) & 1u) {
            const bf16x8 k0 = *(const LAS bf16x8*)(Ks + (16 * kt + fr) * 72 + 8 * fq), k1 = *(const LAS bf16x8*)(Ks + (16 * kt + fr) * 72 + 32 + 8 * fq);
#pragma unroll
            for (int bi = 0; bi < NBLK; ++bi) { st[bi][kt] = __builtin_amdgcn_mfma_f32_16x16x32_bf16(k0, q[bi][0], st[bi][kt], 0, 0, 0); st[bi][kt] = __builtin_amdgcn_mfma_f32_16x16x32_bf16(k1, q[bi][1], st[bi][kt], 0, 0, 0); }
        }
        if (FULL && (kt & 3) == 3) __builtin_amdgcn_sched_barrier(0);
    }
    float rl[NBLK];
#pragma unroll
    for (int bi = 0; bi < NBLK; ++bi) {
        constexpr float CS = 0.125f * 1.4426950408889634f;
        float mx = -1e30f;
#pragma unroll
        for (int kt = 0; kt < 12; ++kt) if ((vval >> kt) & 1u) mx = fmaxf(mx, fmaxf(fmaxf(st[bi][kt][0], st[bi][kt][1]), fmaxf(st[bi][kt][2], st[bi][kt][3])));
        mx = fmaxf(mx, __shfl_xor(mx, 16)); mx = fmaxf(mx, __shfl_xor(mx, 32));
        const float sink2 = sink * 1.4426950408889634f;
        const float m2 = fmaxf(mx * CS, sink2), nm2 = -m2;
        float l = 0.f;
#pragma unroll
        for (int kt = 0; kt < 12; ++kt) {
            if ((vval >> kt) & 1u) { const f32x4 t_ = st[bi][kt] * CS + nm2;
                st[bi][kt] = (f32x4){__builtin_amdgcn_exp2f(t_[0]), __builtin_amdgcn_exp2f(t_[1]), __builtin_amdgcn_exp2f(t_[2]), __builtin_amdgcn_exp2f(t_[3])}; l += (st[bi][kt][0] + st[bi][kt][1]) + (st[bi][kt][2] + st[bi][kt][3]); }
            else st[bi][kt] = (f32x4){0.f, 0.f, 0.f, 0.f};
        }
        l += __shfl_xor(l, 16); l += __shfl_xor(l, 32); l += __builtin_amdgcn_exp2f(sink2 - m2);
        rl[bi] = 1.f / l;
    }
    f32x4 o[NBLK][4];
#pragma unroll
    for (int bi = 0; bi < NBLK; ++bi)
#pragma unroll
        for (int dt = 0; dt < 4; ++dt) o[bi][dt] = (f32x4){0.f, 0.f, 0.f, 0.f};
#pragma unroll
    for (int kp = 0; kp < 6; ++kp) {
        if ((vst >> (2 * kp)) & 1u) {
            bf16x8 pf[NBLK];
#pragma unroll
            for (int bi = 0; bi < NBLK; ++bi) { u32x4 pw; pw.x = pk2(st[bi][2 * kp][0], st[bi][2 * kp][1]); pw.y = pk2(st[bi][2 * kp][2], st[bi][2 * kp][3]); pw.z = pk2(st[bi][2 * kp + 1][0], st[bi][2 * kp + 1][1]); pw.w = pk2(st[bi][2 * kp + 1][2], st[bi][2 * kp + 1][3]); pf[bi] = __builtin_bit_cast(bf16x8, pw); }
#pragma unroll
            for (int dt = 0; dt < 4; ++dt) {
                const u32x2 va = *(const LAS u32x2*)(Vt + (16 * dt + fr) * 200 + 32 * kp + 4 * fq), vb = *(const LAS u32x2*)(Vt + (16 * dt + fr) * 200 + 32 * kp + 16 + 4 * fq);
                const u32x4 vv = (u32x4){va.x, va.y, vb.x, vb.y};
#pragma unroll
                for (int bi = 0; bi < NBLK; ++bi) o[bi][dt] = __builtin_amdgcn_mfma_f32_16x16x32_bf16(__builtin_bit_cast(bf16x8, vv), pf[bi], o[bi][dt], 0, 0, 0);
            }
        }
        if (FULL) __builtin_amdgcn_sched_barrier(0);
    }
#pragma unroll
    for (int bi = 0; bi < NBLK; ++bi) {
        bf16* op = att + (qrow0 + 16 * bi) * DM + hh * 64 + 4 * fq;
#pragma unroll
        for (int dt = 0; dt < 4; ++dt) { u32x2 w; w.x = pk2(o[bi][dt][0] * rl[bi], o[bi][dt][1] * rl[bi]); w.y = pk2(o[bi][dt][2] * rl[bi], o[bi][dt][3] * rl[bi]); *(u32x2*)(op + 16 * dt) = w; }
    }
}
__device__ __forceinline__ void attn_store_piece(LAS bf16* Ks, LAS bf16* Vt, int r, int d8, u32x4 kw, u32x4 vw) {
    *(LAS u32x4*)(Ks + r * 72 + d8) = kw;
    Vt[(d8 + 0) * 200 + r] = (bf16)(vw.x & 0xffffu); Vt[(d8 + 1) * 200 + r] = (bf16)(vw.x >> 16);
    Vt[(d8 + 2) * 200 + r] = (bf16)(vw.y & 0xffffu); Vt[(d8 + 3) * 200 + r] = (bf16)(vw.y >> 16);
    Vt[(d8 + 4) * 200 + r] = (bf16)(vw.z & 0xffffu); Vt[(d8 + 5) * 200 + r] = (bf16)(vw.z >> 16);
    Vt[(d8 + 6) * 200 + r] = (bf16)(vw.w & 0xffffu); Vt[(d8 + 7) * 200 + r] = (bf16)(vw.w >> 16);
}
__device__ __forceinline__ void attn_phase(const Args& a, LAS unsigned char* lds, int G) {
    const int tid = threadIdx.x, lane = tid & 63, wave = __builtin_amdgcn_readfirstlane(tid >> 6), fr = lane & 15, fq = lane >> 4;
    const bf16* zA = (const bf16*)(a.ws + WS_A);
    bf16* att = (bf16*)(a.ws + WS_C);
    LAS bf16* Ks = (LAS bf16*)(lds + AT_KS); LAS bf16* Vt = (LAS bf16*)(lds + AT_VT);
    const float* sinks = a.in[I_SINK];
    for (int sg = blockIdx.x; sg < 256; sg += G) {
        const int bk = sg >> 2, b = bk >> 2, kvh = bk & 3, c0 = (sg & 3) * 16;
        const int r = tid >> 3, d8 = (tid & 7) * 8;
        const bf16* kbase = zA + ((size_t)b * SEQ + r) * ZA_W + 3072 + kvh * 64 + d8;
        for (int cc = c0 - 2; cc <= c0; ++cc) if (cc >= 0) {
            const u32x4 kw = *(const u32x4*)(kbase + (size_t)cc * 64 * ZA_W), vw = *(const u32x4*)(kbase + (size_t)cc * 64 * ZA_W + 256);
            attn_store_piece(Ks, Vt, (cc % 3) * 64 + r, d8, kw, vw);
        }
        __syncthreads();
        const int g = wave >> 1, hh = kvh * 4 + g; const float sink2 = sinks[hh] * 1.4426950408889634f;
        const bf16* qbase = zA + ((size_t)b * SEQ + (wave & 1) * 32 + fr) * ZA_W + 2048 + hh * 64 + 8 * fq;
        bf16x8 qf[2][2];
#pragma unroll
        for (int bi = 0; bi < 2; ++bi) { const bf16* qp = qbase + (size_t)(c0 * 64 + bi * 16) * ZA_W; qf[bi][0] = *(const bf16x8*)qp; qf[bi][1] = *(const bf16x8*)(qp + 32); }
        for (int c = c0; c < c0 + 16; ++c) {
            const bool more = (c + 1 < c0 + 16);
            u32x4 kw = (u32x4){0u, 0u, 0u, 0u}, vw = (u32x4){0u, 0u, 0u, 0u};
            bf16x8 qn[2][2];
#pragma unroll
            for (int bi = 0; bi < 2; ++bi) { qn[bi][0] = qf[bi][0]; qn[bi][1] = qf[bi][1]; }
            { const int cn = more ? c + 1 : c;
              kw = *(const u32x4*)(kbase + (size_t)cn * 64 * ZA_W); vw = *(const u32x4*)(kbase + (size_t)cn * 64 * ZA_W + 256);
#pragma unroll
              for (int bi = 0; bi < 2; ++bi) { const bf16* qp = qbase + (size_t)(cn * 64 + bi * 16) * ZA_W; qn[bi][0] = *(const bf16x8*)qp; qn[bi][1] = *(const bf16x8*)(qp + 32); } }
            unsigned vm = 0xFu << (4 * (c % 3));
            if (c >= 1) vm |= 0xFu << (4 * ((c - 1) % 3));
            if (c >= 2) vm |= 0xFu << (4 * ((c - 2) % 3));
            if (c >= 2) attn_block<2, true>(att, Ks, Vt, (size_t)b * SEQ + c * 64 + (wave & 1) * 32 + fr, hh, sink2 * 0.6931471805599453f, qf, 0xFFFu, 0xFFFu, fr, fq);
            else attn_block<2, false>(att, Ks, Vt, (size_t)b * SEQ + c * 64 + (wave & 1) * 32 + fr, hh, sink2 * 0.6931471805599453f, qf, vm, vm, fr, fq);
#pragma unroll
            for (int bi = 0; bi < 2; ++bi) { qf[bi][0] = qn[bi][0]; qf[bi][1] = qn[bi][1]; }
            __syncthreads();
            if (more) attn_store_piece(Ks, Vt, ((c + 1) % 3) * 64 + r, d8, kw, vw);
            __syncthreads();
        }
    }
    for (int us = blockIdx.x; us < 128; us += G) {
        const int b = us >> 2, kvh = us & 3;
#pragma unroll
        for (int i = 0; i < 3; ++i) {
            const int idx = tid + 512 * i, r = idx >> 3, d8 = (idx & 7) * 8;
            if (r < 160) {
                u32x4 kw, vw;
                if (r < CW) { const float* kp = a.in[I_CK] + ((size_t)(b * CW + r) * NKV + kvh) * HD + d8; const float* vp = a.in[I_CV] + ((size_t)(b * CW + r) * NKV + kvh) * HD + d8;
                    const f32x4 k0 = *(const f32x4*)kp, k1 = *(const f32x4*)(kp + 4), v0 = *(const f32x4*)vp, v1 = *(const f32x4*)(vp + 4);
                    kw.x = pk2(k0.x, k0.y); kw.y = pk2(k0.z, k0.w); kw.z = pk2(k1.x, k1.y); kw.w = pk2(k1.z, k1.w);
                    vw.x = pk2(v0.x, v0.y); vw.y = pk2(v0.z, v0.w); vw.z = pk2(v1.x, v1.y); vw.w = pk2(v1.z, v1.w); }
                else if (r < CW + SSEQ) { const size_t grow = (size_t)MP + (size_t)b * SSEQ + (r - CW);
                    kw = *(const u32x4*)(zA + grow * ZA_W + 3072 + kvh * 64 + d8); vw = *(const u32x4*)(zA + grow * ZA_W + 3328 + kvh * 64 + d8); }
                else { kw = (u32x4){0u, 0u, 0u, 0u}; vw = (u32x4){0u, 0u, 0u, 0u}; }
                attn_store_piece(Ks, Vt, r, d8, kw, vw);
            }
        }
        __syncthreads();
        if (wave < 4) { const int hh = kvh * 4 + wave; const size_t qrow = (size_t)MP + b * SSEQ + fr; const bf16* qp = zA + qrow * ZA_W + 2048 + hh * 64 + 8 * fq;
            bf16x8 qs[2][2]; qs[0][0] = *(const bf16x8*)qp; qs[0][1] = *(const bf16x8*)(qp + 32); qs[1][0] = qs[0][0]; qs[1][1] = qs[0][1];
            attn_block<1>(att, Ks, Vt, qrow, hh, sinks[hh], qs, 0x3FFu, 0x1FFu, fr, fq); }
        __syncthreads();
    }
}
__device__ __forceinline__ void kv_out_phase(const Args& a, int G) {
    const bf16* zA = (const bf16*)(a.ws + WS_A);
    const int gt = blockIdx.x * NTHREADS + threadIdx.x, NGT = G * NTHREADS;
    constexpr int NP = NB * CW * 64, NS = MS * 64;
    for (int i = gt; i < NP + NS; i += NGT) {
        int row_src; float* dst; int col;
        if (i < NP) { const int r = i >> 6; col = (i & 63) * 8; const int b = r >> 7, w = r & 127; row_src = b * SEQ + SEQ - CW + w; dst = a.out + ((col < 256) ? O_KP : O_VP) + (size_t)r * 256 + (col & 255); }
        else { const int j = i - NP; const int r = j >> 6; col = (j & 63) * 8; row_src = MP + r; dst = a.out + ((col < 256) ? O_KS : O_VS) + (size_t)r * 256 + (col & 255); }
        const u32x4 w = *(const u32x4*)(zA + (size_t)row_src * ZA_W + 3072 + col);
        *(f32x4*)dst = (f32x4){bflo(w.x), bfhi(w.x), bflo(w.y), bfhi(w.y)}; *(f32x4*)(dst + 4) = (f32x4){bflo(w.z), bfhi(w.z), bflo(w.w), bfhi(w.w)};
    }
}
__device__ __forceinline__ void final_phase(const Args& a, int G) {
    const int tid = threadIdx.x, lane = tid & 63, wave = tid >> 6;
    const int gw = blockIdx.x * NWAVES + wave, NGW = G * NWAVES;
    const float* ss = (const float*)(a.ws + WS_SS3);
    const bf16* h3 = (const bf16*)(a.ws + WS_B);
    const f32x4* g4 = (const f32x4*)a.in[I_NFIN];
    const f32x4 ga0 = g4[2 * lane], ga1 = g4[2 * lane + 1], gb0 = g4[128 + 2 * lane], gb1 = g4[128 + 2 * lane + 1];
    for (int mb = gw; mb < MT; mb += 4 * NGW) {
        int mr[4]; u32x4 wa[4], wb[4]; float rs[4];
#pragma unroll
        for (int k = 0; k < 4; ++k) { mr[k] = (mb + k * NGW < MT) ? mb + k * NGW : mb; wa[k] = *(const u32x4*)(h3 + (size_t)mr[k] * DM + 8 * lane); wb[k] = *(const u32x4*)(h3 + (size_t)mr[k] * DM + 512 + 8 * lane); }
#pragma unroll
        for (int k = 0; k < 4; ++k) rs[k] = rowscale(ss, mr[k]);
#pragma unroll
        for (int k = 0; k < 4; ++k) {
            f32x4 a0, a1, b0, b1; UNPK8(wa[k], a0, a1); UNPK8(wb[k], b0, b1);
            f32x4* yr = (f32x4*)(a.out + (size_t)mr[k] * DM);
            __builtin_nontemporal_store(a0 * rs[k] * ga0, &yr[2 * lane]); __builtin_nontemporal_store(a1 * rs[k] * ga1, &yr[2 * lane + 1]);
            __builtin_nontemporal_store(b0 * rs[k] * gb0, &yr[128 + 2 * lane]); __builtin_nontemporal_store(b1 * rs[k] * gb1, &yr[128 + 2 * lane + 1]);
        }
    }
}

#define XB_TMO      128
#define XB_XCNT(j)  (256  + 64 * (j))
#define XB_XSUB(j)  (1280 + 64 * (j))
#define XB_XGEN(j)  (2304 + 64 * (j))
#define XB_TOP      3328
#define XB_TOPGEN   3392
#define XCD_BAR_WORDS 3456
#define XB_SPIN_CAP (1u << 18)

__device__ __forceinline__ unsigned xb_ld(unsigned* p)              { return __hip_atomic_load(p, __ATOMIC_RELAXED, __HIP_MEMORY_SCOPE_AGENT); }
__device__ __forceinline__ unsigned xb_add(unsigned* p, unsigned v) { return __hip_atomic_fetch_add(p, v, __ATOMIC_RELAXED, __HIP_MEMORY_SCOPE_AGENT); }
__device__ __forceinline__ unsigned xb_xcc_id() { return (unsigned)__builtin_amdgcn_s_getreg((3 << 11) | 20) & 0xFu; }
#define XB_SPIN(cond, bar) do { unsigned _sp = 0; while (cond) { __builtin_amdgcn_s_sleep(1); \
    if ((++_sp & 255u) == 0u) { if (xb_ld(&(bar)[XB_TMO])) break; if (_sp > XB_SPIN_CAP) { atomicAdd(&(bar)[XB_TMO], 1u); break; } } } } while (0)

struct XcdBarrier {
    unsigned* bar; unsigned x;
    volatile LAS unsigned* st;
};

__device__ __forceinline__ XcdBarrier xcd_barrier_post(unsigned* bar, volatile LAS unsigned* st) {
    XcdBarrier b; b.bar = bar; b.x = xb_xcc_id(); b.st = st;
    if (threadIdx.x == 0) (void)xb_add(&bar[XB_XCNT(b.x)], 1u);
    return b;
}
__device__ __forceinline__ void xcd_barrier_complete(unsigned* bar, unsigned x, unsigned& nloc, unsigned& nx) {
    const unsigned G = gridDim.x * gridDim.y * gridDim.z;
    unsigned sum, cnt, mine, sp = 0u;
    for (;;) {
        sum = 0u; cnt = 0u; mine = 0u;
#pragma unroll
        for (unsigned j = 0; j < 16; ++j) { const unsigned c = xb_ld(&bar[XB_XCNT(j)]); sum += c; cnt += (c > 0u) ? 1u : 0u; mine = (j == x) ? c : mine; }
        if (sum == G) break;
        __builtin_amdgcn_s_sleep(1);
        if ((++sp & 255u) == 0u) { if (xb_ld(&bar[XB_TMO])) break; if (sp > XB_SPIN_CAP) { atomicAdd(&bar[XB_TMO], 1u); break; } }
    }
    nloc = mine > 0u ? mine : 1u; nx = cnt > 0u ? cnt : 1u;
}

__device__ __forceinline__ void xcd_barrier(const XcdBarrier& b) {
    asm volatile("s_waitcnt vmcnt(0)" ::: "memory");
    __syncthreads();
    if (threadIdx.x == 0) {
        unsigned* bar = b.bar;
        __builtin_amdgcn_s_waitcnt(0);
        unsigned nloc = b.st[0], nx = b.st[1];
        if (nloc == 0u) { xcd_barrier_complete(bar, b.x, nloc, nx); b.st[0] = nloc; b.st[1] = nx; }
        const unsigned old = xb_add(&bar[XB_XSUB(b.x)], 1u);
        const unsigned gen = old / nloc;
        if (old + 1u == (gen + 1u) * nloc) {
            __builtin_amdgcn_fence(__ATOMIC_RELEASE, "agent");
            asm volatile("s_waitcnt vmcnt(0)" ::: "memory");
            const unsigned og = xb_add(&bar[XB_TOP], 1u);
            const unsigned tg = og / nx;
            if (og + 1u == (tg + 1u) * nx) xb_add(&bar[XB_TOPGEN], 1u);
            else XB_SPIN(xb_ld(&bar[XB_TOPGEN]) == tg, bar);
            __builtin_amdgcn_fence(__ATOMIC_ACQUIRE, "agent");
            xb_add(&bar[XB_XGEN(b.x)], 1u);
            asm volatile("s_waitcnt vmcnt(0)" ::: "memory");
        } else {
            XB_SPIN(xb_ld(&bar[XB_XGEN(b.x)]) == gen, bar);
            __builtin_amdgcn_fence(__ATOMIC_ACQUIRE, "agent");
            asm volatile("s_waitcnt vmcnt(0)" ::: "memory");
        }
    }
    __syncthreads();
}

__global__ void __launch_bounds__(NTHREADS, 2) mk_fwd(Args a) {
    extern __shared__ __attribute__((aligned(16))) unsigned char lds_raw[];
    LAS unsigned char* lds = (LAS unsigned char*)lds_raw;
    const int G = gridDim.x, lo = a.ph_lo, hi = a.ph_hi;
    const int wid_k = __builtin_amdgcn_readfirstlane((int)(threadIdx.x >> 6));
    unsigned char* ws = a.ws;
#define IN(k) (lo <= (k) && (k) < hi)
#ifndef PROBE_DUP
#define PROBE_DUP 0
#endif
#define REP(k) for (int rep_ = 0; rep_ < (((PROBE_DUP) >> (k)) & 1) + 1; ++rep_)
    volatile LAS unsigned* barst = (volatile LAS unsigned*)(lds + LDS_BARST);
    if (threadIdx.x < 2) barst[threadIdx.x] = 0u;
    __syncthreads();
    XcdBarrier xbar; xbar.bar = (unsigned*)(ws + WS_CTL); xbar.x = 0; xbar.st = barst;
    if (a.coop) xbar = xcd_barrier_post((unsigned*)(ws + WS_CTL), barst);
    unsigned* vcnt = (unsigned*)(ws + WS_CTL) + 8192;
    const unsigned myxcc = xb_xcc_id();
    if (a.coop && threadIdx.x == 0) barst[2] = xb_add(&vcnt[64 * myxcc], 1u);
    __syncthreads();
    const int vrank = (int)barst[2];
    int vc = (int)blockIdx.x;
#define SEAM(k) do { if (a.coop && IN(k) && IN((k) + 1)) { if (a.coop == 2) cg::this_grid().sync(); else xcd_barrier(xbar); } } while (0)
    typedef pg8::StaticOrder SO;
    bf16* h1 = (bf16*)((unsigned char*)a.out + OUT_H1);
    bf16* recb = (bf16*)((unsigned char*)a.out + OUT_REC);

    if (IN(0)) p0_prologue(a, lds, G);
    SEAM(0);
    if (a.coop && (G & 7) == 0) {
        bool ok = true;
#pragma unroll
        for (int j = 0; j < 16; ++j) { const unsigned cj = xb_ld(&vcnt[64 * j]); ok = ok && (cj == (j < 8 ? (unsigned)(G >> 3) : 0u)); }
        if (ok) vc = vrank * 8 + (int)myxcc;
    }
    vc = __builtin_amdgcn_readfirstlane(vc);
    if (IN(1)) {
        pg8::Gemm g{(const bf16*)(ws + WS_B), (const bf16*)(ws + WS_WGU1), MT, DIN, DM, DM}; SkewOrder S; S.init(MT, DIN, G, vc);
        EpiSwiGLU<true> E{(bf16*)(ws + WS_A), (const float*)(ws + WS_SS0)};
        pg8::gemm_phase<EpiSwiGLU<true>, SkewOrder, true, true>(lds, g, S, E);
    }
    SEAM(1);
    if (IN(2)) {
        pg8::Gemm g{(const bf16*)(ws + WS_A), (const bf16*)(ws + WS_WD1), MP, DM, DFF, DFF};
        typedef ComboOrder<DM / 256, DFF / 256, 256> CO; typedef EpiResSplit<DM / 256, 256> ERS;
        CO S; S.so.init(MP, DM, G, vc); S.sp.G = G; S.sp.c = vc; S.rounds = (vc < (MP / 256) * (DM / 256)) ? ((MP / 256) * (DM / 256) - vc + G - 1) / G : 0;
        ERS E{{(const bf16*)(ws + WS_B), nullptr, h1, (float*)(ws + WS_SS1), 0.5f}, {(f32x4*)(ws + WS_PART)}};
        pg8::gemm_phase<ERS, CO, true, true>(lds, g, S, E);
        if (a.coop) xcd_barrier(xbar);
        splitk_fixup_res<DFF / 256>((const bf16*)E.R.res, (bf16*)E.R.out, E.R.ss, 0.5f, (const f32x4*)(ws + WS_PART), DM / 256, G, wid_k);
    }
    SEAM(2);
    if (IN(3)) {
        pg8::Gemm g{h1, (const bf16*)(ws + WS_WIN), MT, DIN, DM, DM}; SkewOrder S; S.init(MT, DIN, G, vc);
        EpiWin E{(bf16*)(ws + WS_A), (bf16*)(ws + WS_B), (const float*)(ws + WS_SS1)};
        pg8::gemm_phase<EpiWin, SkewOrder, true, true>(lds, g, S, E);
    }
    SEAM(3);
    if (IN(4)) { REP(10) rec_phase(a, lds, G); REP(11) attn_phase(a, lds, G); kv_out_phase(a, G); }
    SEAM(4);
    if (IN(5)) {
        { pg8::Gemm g{recb, (const bf16*)(ws + WS_WBR), MT, DM, DM, DM}; SO S; S.init(MT, DM, G, vc);
          EpiBranch<false> E{(bf16*)(ws + WS_A), (const bf16*)(ws + WS_B), 0};
          pg8::gemm_phase<EpiBranch<false>, SO, true, true>(lds, g, S, E); }
        { pg8::Gemm g{(const bf16*)(ws + WS_C), (const bf16*)(ws + WS_WBA), MT, DM, DM, DM}; SO S; S.init(MT, DM, G, vc);
          EpiBranch<true> E{(bf16*)(ws + WS_A), (const bf16*)(ws + WS_B), 1024};
          pg8::gemm_phase<EpiBranch<true>, SO, true, true>(lds, g, S, E); }
    }
    SEAM(5);
    if (IN(6)) {
        pg8::Gemm g{(const bf16*)(ws + WS_A), (const bf16*)(ws + WS_WOUT), MP, DM, DM, DM};
        typedef ComboOrder<DM / 256, DM / 256, 256> CO6; typedef EpiResSplit<DM / 256, 256> ERS6;
        CO6 S; S.so.init(MP, DM, G, vc); S.sp.G = G; S.sp.c = vc; S.rounds = (vc < (MP / 256) * (DM / 256)) ? ((MP / 256) * (DM / 256) - vc + G - 1) / G : 0;
        ERS6 E{{h1, nullptr, (bf16*)(ws + WS_B), (float*)(ws + WS_SS2), 1.0f}, {(f32x4*)(ws + WS_PART)}};
        pg8::gemm_phase<ERS6, CO6, true, true>(lds, g, S, E);
        if (a.coop) xcd_barrier(xbar);
        splitk_fixup_res<DM / 256>((const bf16*)E.R.res, (bf16*)E.R.out, E.R.ss, 1.0f, (const f32x4*)(ws + WS_PART), DM / 256, G, wid_k);
    }
    SEAM(6);
    if (IN(7)) {
        pg8::Gemm g{(const bf16*)(ws + WS_B), (const bf16*)(ws + WS_WGU2), MT, DIN, DM, DM}; SkewOrder S; S.init(MT, DIN, G, vc);
        EpiSwiGLU<true> E{(bf16*)(ws + WS_A), (const float*)(ws + WS_SS2)};
        pg8::gemm_phase<EpiSwiGLU<true>, SkewOrder, true, true>(lds, g, S, E);
    }
    SEAM(7);
    if (IN(8)) {
        pg8::Gemm g{(const bf16*)(ws + WS_A), (const bf16*)(ws + WS_WD2), MP, DM, DFF, DFF};
        typedef ComboOrder<DM / 256, DFF / 256, 256> CO; typedef EpiResSplit<DM / 256, 256> ERS;
        CO S; S.so.init(MP, DM, G, vc); S.sp.G = G; S.sp.c = vc; S.rounds = (vc < (MP / 256) * (DM / 256)) ? ((MP / 256) * (DM / 256) - vc + G - 1) / G : 0;
        ERS E{{(const bf16*)(ws + WS_B), nullptr, (bf16*)(ws + WS_B), (float*)(ws + WS_SS3), 0.5f}, {(f32x4*)(ws + WS_PART)}};
        pg8::gemm_phase<ERS, CO, true, true>(lds, g, S, E);
        if (a.coop) xcd_barrier(xbar);
        splitk_fixup_res<DFF / 256>((const bf16*)E.R.res, (bf16*)E.R.out, E.R.ss, 0.5f, (const f32x4*)(ws + WS_PART), DM / 256, G, wid_k);
    }
    SEAM(8);
    if (IN(9)) final_phase(a, G);
#undef IN
#undef SEAM
}

#ifndef MK_ONE_LAUNCH
#define MK_ONE_LAUNCH 1
#endif
extern "C" void kernel_launch(void* const* d_in, const int* in_sizes, int n_in, void* d_out, int out_size, void* d_ws, size_t ws_size, hipStream_t stream) {
    static int grid = 0;
    if (grid == 0) {
        if (n_in != 27 || in_sizes[0] != MP * DM || (size_t)out_size != O_END || ws_size < WS_END) {
            fprintf(stderr, "kernel_launch: unexpected shapes: n_in %d in0 %d out %d ws %zu (need %zu)\n", n_in, n_in > 0 ? in_sizes[0] : -1, out_size, ws_size, (size_t)WS_END); grid = -1; return; }
        int dev = 0, cus = 0, per_cu = 0;
        if (hipGetDevice(&dev) != hipSuccess || hipDeviceGetAttribute(&cus, hipDeviceAttributeMultiprocessorCount, dev) != hipSuccess) { grid = -1; return; }
        if (hipFuncSetAttribute((const void*)mk_fwd, hipFuncAttributeMaxDynamicSharedMemorySize, LDS_BYTES) != hipSuccess) { fprintf(stderr, "kernel_launch: hipFuncSetAttribute failed\n"); grid = -1; return; }
        if (hipOccupancyMaxActiveBlocksPerMultiprocessor(&per_cu, (const void*)mk_fwd, NTHREADS, LDS_BYTES) != hipSuccess || per_cu < 1) { fprintf(stderr, "kernel_launch: occupancy query gave %d\n", per_cu); per_cu = 1; }
        (void)hipGetLastError();
        grid = cus * per_cu;
        fprintf(stderr, "kernel_launch: grid %d (cus %d x %d)\n", grid, cus, per_cu);
    }
    if (grid < 0) return;
    Args a{};
    for (int i = 0; i < 27; ++i) a.in[i] = (const float*)d_in[i];
    a.out = (float*)d_out; a.ws = (unsigned char*)d_ws;
#if MK_ONE_LAUNCH
    if (hipMemsetAsync((char*)d_ws + WS_CTL, 0, CTL_ZERO_BYTES, stream) != hipSuccess) { fprintf(stderr, "kernel_launch: hipMemsetAsync failed\n"); return; }
    a.ph_lo = 0; a.ph_hi = N_PHASES; a.coop = 1;
    void* args[] = {&a};
    hipError_t e = hipLaunchCooperativeKernel((const void*)mk_fwd, dim3(grid), dim3(NTHREADS), args, LDS_BYTES, stream);
    if (e != hipSuccess) fprintf(stderr, "kernel_launch: cooperative launch failed: %s (grid %d)\n", hipGetErrorString(e), grid);
#else
    for (int p = 0; p < N_PHASES; ++p) {
        a.ph_lo = p; a.ph_hi = p + 1; a.coop = 0;
        hipLaunchKernelGGL(mk_fwd, dim3(grid), dim3(NTHREADS), LDS_BYTES, stream, a);
    }
#endif
}
```
